# Optimizing an MI355X kernel written in HIP

```python
import math
import jax, jax.numpy as jnp
from jax import lax
import numpy as np

D_MODEL = 1024
BATCH = 4
SEQ = 8192
DEPTH = 1
DEC_BATCH = 4
DEC_SEQ = 4096
PAST_LEN = 128

GRID_W = 64
HEAD_DIM = 64
N_HEADS_A = 8
N_KV_A = 2
N_HEADS_B = 8
N_KV_B = 2
Q_BLOCK = 128
WINDOW = 128
N_BUCKETS = 32
MAX_DISTANCE = 128
ROPE_THETA = 10000.0
AXIS_DIM = HEAD_DIM // 2
D_FF = 2816
EPS = 1e-6
NEG_INF = -1e30
SPLIT_SIZES = (N_HEADS_A * HEAD_DIM, N_KV_A * HEAD_DIM, N_KV_A * HEAD_DIM,
               N_HEADS_B * HEAD_DIM, N_KV_B * HEAD_DIM, N_KV_B * HEAD_DIM,
               D_MODEL, D_MODEL)
IN_COLS = sum(SPLIT_SIZES)

kernel_name = "hybrid_axial_window_encoder"


def rmsnorm(x, g):
    xf = x.astype(jnp.float32)
    y = xf * lax.rsqrt(jnp.mean(xf * xf, axis=-1, keepdims=True) + EPS) * g.astype(jnp.float32)
    return y.astype(x.dtype)


def swiglu_ffn(x, w_in, w_out):
    a, b = jnp.split(x @ w_in, 2, axis=-1)
    return (jax.nn.silu(a) * b) @ w_out


def t5_bucket(rel):
    nb = N_BUCKETS // 2
    max_exact = nb // 2
    ret = jnp.where(rel > 0, nb, 0)
    n = jnp.abs(rel)
    large = max_exact + (jnp.log(jnp.maximum(n, 1).astype(jnp.float32) / max_exact)
                         / math.log(MAX_DISTANCE / max_exact) * (nb - max_exact)).astype(jnp.int32)
    large = jnp.minimum(large, nb - 1)
    return ret + jnp.where(n < max_exact, n, large)


def axial_rope(x):
    B, T, H, _ = x.shape
    rows = T // GRID_W
    grid_r, grid_c = jnp.meshgrid(jnp.arange(rows, dtype=jnp.float32),
                                  jnp.arange(GRID_W, dtype=jnp.float32), indexing="ij")
    pos = jnp.stack([grid_r.reshape(-1), grid_c.reshape(-1)], axis=-1)
    inv = ROPE_THETA ** (-jnp.arange(0, AXIS_DIM, 2, dtype=jnp.float32) / AXIS_DIM)
    ang = pos[:, :, None] * inv
    cos = jnp.cos(ang)[None, :, None]
    sin = jnp.sin(ang)[None, :, None]
    xf = x.astype(jnp.float32).reshape(B, T, H, 2, 2, AXIS_DIM // 2)
    x1 = xf[..., 0, :]
    x2 = xf[..., 1, :]
    out = jnp.stack([x1 * cos - x2 * sin, x2 * cos + x1 * sin], axis=-2)
    return out.reshape(x.shape).astype(x.dtype)


def dense_attention_blocks(q, k, v):
    B, T, KV, G, D = q.shape
    nb = T // Q_BLOCK
    scale = 1.0 / math.sqrt(D)
    kf = k.astype(jnp.float32)
    vf = v.astype(jnp.float32)
    qb = q.reshape(B, nb, Q_BLOCK, KV, G, D).transpose(1, 0, 2, 3, 4, 5)

    def one_block(qblk):
        s = jnp.einsum("bqkgd,bskd->bkgqs", qblk.astype(jnp.float32), kf) * scale
        p = jax.nn.softmax(s, axis=-1)
        return jnp.einsum("bkgqs,bskd->bqkgd", p, vf)

    o = lax.map(one_block, qb)
    return o.transpose(1, 0, 2, 3, 4, 5).reshape(B, T, KV * G * D).astype(q.dtype)


def window_sink_attention(q, k, v, rel_bias, sink):
    B, T, KV, G, D = q.shape
    nb = T // Q_BLOCK
    scale = 1.0 / math.sqrt(D)
    pad = ((0, 0), (Q_BLOCK, Q_BLOCK), (0, 0), (0, 0))
    kp = jnp.pad(k.astype(jnp.float32), pad).reshape(B, nb + 2, Q_BLOCK, KV, D)
    vp = jnp.pad(v.astype(jnp.float32), pad).reshape(B, nb + 2, Q_BLOCK, KV, D)
    k_band = jnp.concatenate([kp[:, :-2], kp[:, 1:-1], kp[:, 2:]], axis=2)
    v_band = jnp.concatenate([vp[:, :-2], vp[:, 1:-1], vp[:, 2:]], axis=2)
    qb = q.astype(jnp.float32).reshape(B, nb, Q_BLOCK, KV, G, D)
    rel = jnp.arange(3 * Q_BLOCK)[None, :] - Q_BLOCK - jnp.arange(Q_BLOCK)[:, None]
    bias = rel_bias.astype(jnp.float32)[t5_bucket(rel)]
    bias = bias.transpose(2, 0, 1).reshape(KV, G, Q_BLOCK, 3 * Q_BLOCK)
    key_pos = jnp.arange(nb)[:, None] * Q_BLOCK - Q_BLOCK + jnp.arange(3 * Q_BLOCK)[None, :]
    in_range = (key_pos >= 0) & (key_pos < T)
    mask = (jnp.abs(rel) <= WINDOW)[None] & in_range[:, None, :]
    s = jnp.einsum("bnqkgd,bnskd->bnkgqs", qb, k_band) * scale + bias[None, None]
    s = jnp.where(mask[None, :, None, None], s, NEG_INF)
    sink_col = jnp.broadcast_to(sink.astype(jnp.float32).reshape(1, 1, KV, G, 1, 1),
                                s.shape[:-1] + (1,))
    p = jax.nn.softmax(jnp.concatenate([s, sink_col], axis=-1), axis=-1)[..., :-1]
    o = jnp.einsum("bnkgqs,bnskd->bnqkgd", p, v_band)
    return o.reshape(B, T, KV * G * D).astype(q.dtype)


def token_mixing(h, w_in, q_norm_a, k_norm_a, sink_b, w_branch_a, w_branch_b, w_out, rel_bias):
    B, T, _ = h.shape
    proj = h @ w_in
    offsets = list(np.cumsum(SPLIT_SIZES)[:-1])
    qa, ka, va, qb, kb, vb, ga, gb = jnp.split(proj, offsets, axis=-1)
    qa = axial_rope(rmsnorm(qa.reshape(B, T, N_HEADS_A, HEAD_DIM), q_norm_a))
    ka = axial_rope(rmsnorm(ka.reshape(B, T, N_KV_A, HEAD_DIM), k_norm_a))
    qa = qa.reshape(B, T, N_KV_A, N_HEADS_A // N_KV_A, HEAD_DIM)
    va = va.reshape(B, T, N_KV_A, HEAD_DIM)
    ya = dense_attention_blocks(qa, ka, va) @ w_branch_a
    qb = qb.reshape(B, T, N_KV_B, N_HEADS_B // N_KV_B, HEAD_DIM)
    kb = kb.reshape(B, T, N_KV_B, HEAD_DIM)
    vb = vb.reshape(B, T, N_KV_B, HEAD_DIM)
    yb = window_sink_attention(qb, kb, vb, rel_bias, sink_b) @ w_branch_b
    merged = jax.nn.sigmoid(ga) * ya + jax.nn.sigmoid(gb) * yb
    return merged @ w_out


def trunk(x, norm_ffn1, w_ffn1_in, w_ffn1_out, norm_mix, w_in, q_norm_a, k_norm_a, sink_b,
          w_branch_a, w_branch_b, w_out, norm_ffn2, w_ffn2_in, w_ffn2_out, rel_bias, norm_final):
    for l in range(DEPTH):
        x = x + 0.5 * swiglu_ffn(rmsnorm(x, norm_ffn1[l]), w_ffn1_in[l], w_ffn1_out[l])
        x = x + token_mixing(rmsnorm(x, norm_mix[l]), w_in[l], q_norm_a[l], k_norm_a[l], sink_b[l],
                             w_branch_a[l], w_branch_b[l], w_out[l], rel_bias)
        x = x + 0.5 * swiglu_ffn(rmsnorm(x, norm_ffn2[l]), w_ffn2_in[l], w_ffn2_out[l])
    return rmsnorm(x, norm_final)


def setup_inputs(seed: int = 0) -> dict:
    key = jax.random.key(seed)
    ks = jax.random.split(key, 20)
    f32 = jnp.float32

    def nrm(k, shape, scale):
        return jax.random.normal(k, shape, f32) * scale

    def gain(k, shape):
        return 1.0 + 0.05 * jax.random.normal(k, shape, f32)

    wa = N_HEADS_A * HEAD_DIM
    wb = N_HEADS_B * HEAD_DIM
    return {
        "x_prompt": jax.random.normal(ks[0], (BATCH, SEQ, D_MODEL), f32),
        "x_sample": jax.random.normal(ks[1], (DEC_BATCH, DEC_SEQ, D_MODEL), f32),
        "norm_ffn1": gain(ks[2], (DEPTH, D_MODEL)),
        "w_ffn1_in": nrm(ks[3], (DEPTH, D_MODEL, 2 * D_FF), D_MODEL ** -0.5),
        "w_ffn1_out": nrm(ks[4], (DEPTH, D_FF, D_MODEL), D_FF ** -0.5),
        "norm_mix": gain(ks[5], (DEPTH, D_MODEL)),
        "w_in": nrm(ks[6], (DEPTH, D_MODEL, IN_COLS), D_MODEL ** -0.5),
        "q_norm_a": gain(ks[7], (DEPTH, HEAD_DIM)),
        "k_norm_a": gain(ks[8], (DEPTH, HEAD_DIM)),
        "sink_b": nrm(ks[9], (DEPTH, N_HEADS_B), 0.5),
        "w_branch_a": nrm(ks[10], (DEPTH, wa, D_MODEL), wa ** -0.5),
        "w_branch_b": nrm(ks[11], (DEPTH, wb, D_MODEL), wb ** -0.5),
        "w_out": nrm(ks[12], (DEPTH, D_MODEL, D_MODEL), D_MODEL ** -0.5),
        "norm_ffn2": gain(ks[13], (DEPTH, D_MODEL)),
        "w_ffn2_in": nrm(ks[14], (DEPTH, D_MODEL, 2 * D_FF), D_MODEL ** -0.5),
        "w_ffn2_out": nrm(ks[15], (DEPTH, D_FF, D_MODEL), D_FF ** -0.5),
        "rel_bias": nrm(ks[16], (N_BUCKETS, N_HEADS_B), 0.1),
        "norm_final": gain(ks[17], (D_MODEL,)),
    }


def reference(x_prompt, x_sample, norm_ffn1, w_ffn1_in, w_ffn1_out, norm_mix, w_in, q_norm_a, k_norm_a,
              sink_b, w_branch_a, w_branch_b, w_out, norm_ffn2, w_ffn2_in, w_ffn2_out, rel_bias, norm_final):
    y_prompt = trunk(x_prompt, norm_ffn1, w_ffn1_in, w_ffn1_out, norm_mix, w_in, q_norm_a, k_norm_a, sink_b,
                     w_branch_a, w_branch_b, w_out, norm_ffn2, w_ffn2_in, w_ffn2_out, rel_bias, norm_final)
    y_sample = trunk(x_sample, norm_ffn1, w_ffn1_in, w_ffn1_out, norm_mix, w_in, q_norm_a, k_norm_a, sink_b,
                     w_branch_a, w_branch_b, w_out, norm_ffn2, w_ffn2_in, w_ffn2_out, rel_bias, norm_final)
    return (y_prompt, y_sample)
```

```cpp
#include <hip/hip_runtime.h>
#include <hip/hip_cooperative_groups.h>
#include <hip/hip_bf16.h>
#include <cstdio>
#include <cstdint>
#include <cmath>
namespace cg = cooperative_groups;
constexpr int DM = 1024, DFF = 2816, NIN = 3584, MP = 32768  , MS = 16384  , M = MP + MS;
constexpr int TP = 8192, TS = 4096;
constexpr float EPS = 1e-6f;
constexpr float LOG2E = 1.4426950408889634f;
constexpr float C2 = 0.125f * LOG2E;
constexpr size_t MiB = 1u << 20;
constexpr size_t WS_W1IN = 1 * MiB, WS_W1OUT = 12 * MiB, WS_WIN = 18 * MiB, WS_WA = 25 * MiB, WS_WB = 26 * MiB, WS_WO = 27 * MiB, WS_W2IN = 29 * MiB, WS_W2OUT = 40 * MiB;
constexpr size_t WS_ROPE = 46 * MiB, WS_XN = 48 * MiB, WS_ACT = 144 * MiB;
constexpr size_t WS_QA = 144 * MiB, WS_QB = 192 * MiB, WS_KA = 240 * MiB, WS_VA = 252 * MiB, WS_KB = 264 * MiB, WS_VB = 276 * MiB, WS_GA = 288 * MiB, WS_GB = 384 * MiB, WS_SSQ = 480 * MiB, WS_END = 483 * MiB;
static_assert(WS_ACT + (size_t)M * DFF * 2 <= WS_END && WS_XN + (size_t)M * DM * 2 <= WS_ACT && WS_GB + (size_t)M * DM * 2 <= WS_END, "ws map");
namespace pg8 {
#define PG8_LAS __attribute__((address_space(3)))
typedef unsigned short bf16_t;
typedef short bf16x8 __attribute__((ext_vector_type(8)));
typedef float f32x4 __attribute__((ext_vector_type(4)));
typedef unsigned u32x4 __attribute__((ext_vector_type(4)));
constexpr int BM = 256, BK = 64, HALF = 128, HTB = HALF * BK * 2  , STAGE_BYTES = 8 * HTB, NXCD = 8, WGM = 8;

__host__ __device__ __forceinline__ int lds_byte(int r, int c) { const int st = (r >> 4) * 2 + (c >> 5), rr = r & 15, cc = c & 31, ob = rr * 64 + cc * 2; return st * 1024 + (ob ^ (((ob >> 9) & 1) << 5)); }
__host__ __device__ __forceinline__ void stage_rc(int b, int& R, int& C) { const int st = b / 1024, sb = b % 1024, swz = sb ^ (((sb >> 9) & 1) << 5); R = (st >> 1) * 16 + swz / 64; C = (st & 1) * 32 + (swz % 64) / 2; }
__host__ __device__ __forceinline__ int perm32(int rho) { const int n = rho >> 4, i = rho & 15; return 8 * (i >> 2) + 4 * n + (i & 3); }

struct Unit { int pm, pn; };
struct Gemm { const bf16_t* A; const bf16_t* Bt; int M, N, K; };

struct StaticOrder {
    int nM, nN, nwg, G, c;
    __host__ __device__ void init(int M, int N, int G_, int c_) { nM = M / BM; nN = N / BM; nwg = nM * nN; G = G_; c = c_; }
    __host__ __device__ bool next(int i, Unit& u) const {
        const long L = (long)i * G + c; if (L >= nwg) return false;
        int wgid = (int)L; { const int q = nwg / NXCD, r = nwg % NXCD, xcd = wgid % NXCD, off = wgid / NXCD; wgid = (xcd < r ? xcd * (q + 1) : r * (q + 1) + (xcd - r) * q) + off; }
        const int nig = WGM * nN, gid = wgid / nig, fm = gid * WGM, gsz = (nM - fm) < WGM ? (nM - fm) : WGM;
        u.pm = fm + ((wgid % nig) % gsz); u.pn = (wgid % nig) / gsz; return true;
    }
    __device__ __forceinline__ void a_ready(const Unit&) const {}
    __device__ __forceinline__ void done(const Unit&) const {}
};

typedef float f32x2_c __attribute__((ext_vector_type(2))); typedef __bf16 bf16x2_c __attribute__((ext_vector_type(2)));
__device__ __forceinline__ unsigned cvt_pk_bf16(float lo, float hi) { f32x2_c v = {lo, hi}; bf16x2_c b = __builtin_convertvector(v, bf16x2_c); return __builtin_bit_cast(unsigned, b); }
typedef unsigned u32x2 __attribute__((ext_vector_type(2)));
typedef unsigned u32x4e __attribute__((ext_vector_type(4)));
__device__ __forceinline__ u32x2 pack4(f32x4 v) { u32x2 w; w.x = cvt_pk_bf16(v[0], v[1]); w.y = cvt_pk_bf16(v[2], v[3]); return w; }
__device__ __forceinline__ f32x4 unpack4(u32x2 w) { f32x4 v; v[0] = __uint_as_float(w.x << 16); v[1] = __uint_as_float(w.x & 0xffff0000u); v[2] = __uint_as_float(w.y << 16); v[3] = __uint_as_float(w.y & 0xffff0000u); return v; }
__device__ __forceinline__ float sigmoid_f(float v) { return __builtin_amdgcn_rcpf(1.0f + __builtin_amdgcn_exp2f(-1.4426950408889634f * v)); }

__device__ __forceinline__ void rows_rinv(const float* ssq, int row0, int fq, float (&ri)[2][4]);
struct EpiSwiglu {
    static constexpr bool PERM = true, AFTER_DRAIN = false;
    unsigned char* ws; bool scaled;
    __device__ __forceinline__ void operator()(const f32x4 (&acc)[2][2][4][2], const Unit& u, int wr, int wc, int fr, int fq) const {
        const int row0 = u.pm * BM + wr * 64 + fr, col0 = u.pn * HALF + wc * 32 + 8 * fq;
        float ri[2][4];
        if (scaled) rows_rinv((const float*)(ws + WS_SSQ), row0, fq, ri);
        else {
#pragma unroll
            for (int ai = 0; ai < 2; ++ai)
#pragma unroll
                for (int m = 0; m < 4; ++m) ri[ai][m] = 1.0f; }
#pragma unroll
        for (int ai = 0; ai < 2; ++ai)
#pragma unroll
            for (int m = 0; m < 4; ++m) { const int row = row0 + ai * HALF + m * 16; bf16_t* rowp = (bf16_t*)(ws + WS_ACT) + (size_t)row * DFF + col0; u32x4e w;
#pragma unroll
                for (int n = 0; n < 2; ++n) { const f32x4 a = acc[ai][0][m][n] * ri[ai][m], b = acc[ai][1][m][n] * ri[ai][m]; f32x4 o;
#pragma unroll
                    for (int i = 0; i < 4; ++i) o[i] = a[i] * sigmoid_f(a[i]) * b[i];
                    const u32x2 p = pack4(o); w[2 * n] = p.x; w[2 * n + 1] = p.y; }
                *(u32x4e*)rowp = w; }
    }
};
template <bool NORMOUT> struct EpiResid {
    static constexpr bool PERM = true, AFTER_DRAIN = false;
    const float* base0; const float* base1; int split; float* out; float s; unsigned char* ws;
    __device__ __forceinline__ void operator()(const f32x4 (&acc)[2][2][4][2], const Unit& u, int wr, int wc, int fr, int fq) const {
        const int row0 = u.pm * BM + wr * 64 + fr, col0 = u.pn * BM + wc * 32 + 8 * fq;
        const float* base = (u.pm * BM < split) ? base0 : base1; bf16_t* const xn = (bf16_t*)(ws + WS_XN); float* const ssq = (float*)(ws + WS_SSQ);
#pragma unroll
        for (int ai = 0; ai < 2; ++ai)
#pragma unroll
        for (int mh = 0; mh < 4; mh += 2) {
            f32x4 pre[4][2][2];
#pragma unroll
            for (int m = mh; m < mh + 2; ++m)
#pragma unroll
                for (int bj = 0; bj < 2; ++bj)
#pragma unroll
                    for (int n = 0; n < 2; ++n) pre[m][bj][n] = *(const f32x4*)(base + (size_t)(row0 + ai * HALF + m * 16) * 1024 + col0 + bj * HALF + n * 4);
            asm volatile("" ::: "memory");
#pragma unroll
            for (int m = mh; m < mh + 2; ++m) { const int row = row0 + ai * HALF + m * 16; const size_t off = (size_t)row * 1024 + col0; float ss = 0.f;
#pragma unroll
                for (int bj = 0; bj < 2; ++bj) { u32x4e w;
#pragma unroll
                    for (int n = 0; n < 2; ++n) { const f32x4 o = pre[m][bj][n] + acc[ai][bj][m][n] * s;
                        *(f32x4*)(out + off + bj * HALF + n * 4) = o;
                        if (NORMOUT) { const u32x2 p = pack4(o); w[2 * n] = p.x; w[2 * n + 1] = p.y; ss += (o[0] * o[0] + o[1] * o[1]) + (o[2] * o[2] + o[3] * o[3]); } }
                    if (NORMOUT) *(u32x4e*)(xn + off + bj * HALF) = w; }
                if (NORMOUT) { ss += __shfl_xor(ss, 16); ss += __shfl_xor(ss, 32); if (fq == 0) ssq[(size_t)row * 16 + u.pn * 4 + wc] = ss; } }
            asm volatile("" ::: "memory");
        }
    }
};
__device__ __forceinline__ void rows_rinv(const float* ssq, int row0, int fq, float (&ri)[2][4]) {
    f32x4 p[2][4];
#pragma unroll
    for (int ai = 0; ai < 2; ++ai)
#pragma unroll
        for (int m = 0; m < 4; ++m) p[ai][m] = *(const f32x4*)(ssq + (size_t)(row0 + ai * HALF + m * 16) * 16 + 4 * fq);
#pragma unroll
    for (int ai = 0; ai < 2; ++ai)
#pragma unroll
        for (int m = 0; m < 4; ++m) { float t = (p[ai][m][0] + p[ai][m][1]) + (p[ai][m][2] + p[ai][m][3]); t += __shfl_xor(t, 16); t += __shfl_xor(t, 32);
            ri[ai][m] = 1.0f / sqrtf(t * (1.0f / 1024.0f) + 1e-6f); }
}
template <bool ADD> struct EpiGate {
    static constexpr bool PERM = true, AFTER_DRAIN = false;
    unsigned char* ws;
    __device__ __forceinline__ void operator()(const f32x4 (&acc)[2][2][4][2], const Unit& u, int wr, int wc, int fr, int fq) const {
        const int row0 = u.pm * BM + wr * 64 + fr, col0 = u.pn * BM + wc * 32 + 8 * fq;
        const bf16_t* const G = (const bf16_t*)(ws + (ADD ? WS_GB : WS_GA)); bf16_t* const Mg = (bf16_t*)(ws + WS_GA);
#pragma unroll
        for (int ai = 0; ai < 2; ++ai)
#pragma unroll
        for (int mh = 0; mh < 4; mh += 2) {
            u32x2 pg[4][2][2], pm_[4][2][2];
#pragma unroll
            for (int m = mh; m < mh + 2; ++m)
#pragma unroll
                for (int bj = 0; bj < 2; ++bj)
#pragma unroll
                    for (int n = 0; n < 2; ++n) { const size_t off = (size_t)(row0 + ai * HALF + m * 16) * 1024 + col0 + bj * HALF + n * 4;
                        pg[m][bj][n] = *(const u32x2*)(G + off); if (ADD) pm_[m][bj][n] = *(const u32x2*)(Mg + off); }
            asm volatile("" ::: "memory");
#pragma unroll
            for (int m = mh; m < mh + 2; ++m)
#pragma unroll
                for (int bj = 0; bj < 2; ++bj)
#pragma unroll
                    for (int n = 0; n < 2; ++n) { const size_t off = (size_t)(row0 + ai * HALF + m * 16) * 1024 + col0 + bj * HALF + n * 4;
                        f32x4 o = unpack4(pg[m][bj][n]) * acc[ai][bj][m][n]; if (ADD) o = o + unpack4(pm_[m][bj][n]);
                        *(u32x2*)(Mg + off) = pack4(o); }
            asm volatile("" ::: "memory");
        }
    }
};
struct EpiMix {
    static constexpr bool PERM = true, AFTER_DRAIN = false;
    unsigned char* ws; const float *qn, *kn;
    __device__ __forceinline__ void operator()(const f32x4 (&acc)[2][2][4][2], const Unit& u, int wr, int wc, int fr, int fq) const {
        const int pn = u.pn, row0 = u.pm * BM + wr * 64 + fr; const float c2 = C2;
        const float* const rope = (const float*)(ws + WS_ROPE);
        float ri8[2][4]; rows_rinv((const float*)(ws + WS_SSQ), row0, fq, ri8);
        if (pn >= 6) {
            bf16_t* G = (bf16_t*)(ws + (pn < 10 ? WS_GA : WS_GB)); const int col0 = (pn < 10 ? pn - 6 : pn - 10) * BM + wc * 32 + 8 * fq;
#pragma unroll
            for (int ai = 0; ai < 2; ++ai)
#pragma unroll
                for (int m = 0; m < 4; ++m) { const int row = row0 + ai * HALF + m * 16; bf16_t* rowp = G + (size_t)row * 1024 + col0; const float ri = ri8[ai][m];
#pragma unroll
                    for (int bj = 0; bj < 2; ++bj) { u32x4e w;
#pragma unroll
                        for (int n = 0; n < 2; ++n) { const f32x4 v = acc[ai][bj][m][n] * ri; f32x4 o;
#pragma unroll
                            for (int i = 0; i < 4; ++i) o[i] = sigmoid_f(v[i]);
                            const u32x2 p = pack4(o); w[2 * n] = p.x; w[2 * n + 1] = p.y; }
                        *(u32x4e*)(rowp + bj * HALF) = w; } }
            return;
        }
        int kind, pitch, hc; bf16_t* dst;
        if (pn < 2)       { dst = (bf16_t*)(ws + WS_QA); pitch = 512; hc = (4 * pn + wc) * 64; kind = 0; }
        else if (pn == 2) { pitch = 128; if (wc < 2) { dst = (bf16_t*)(ws + WS_KA); hc = wc * 64; kind = 1; } else { dst = (bf16_t*)(ws + WS_VA); hc = (wc - 2) * 64; kind = 2; } }
        else if (pn < 5)  { dst = (bf16_t*)(ws + WS_QB); pitch = 512; hc = (4 * (pn - 3) + wc) * 64; kind = 3; }
        else              { pitch = 128; kind = 2; if (wc < 2) { dst = (bf16_t*)(ws + WS_KB); hc = wc * 64; } else { dst = (bf16_t*)(ws + WS_VB); hc = (wc - 2) * 64; } }
        const int dl = 32 * (fq >> 1) + 8 * (fq & 1);
        if (kind < 2) {
            const float* gn = kind == 0 ? qn : kn; const float osc = kind == 0 ? c2 : 1.0f; const int axis = fq >> 1, jb = 8 * (fq & 1);
#pragma unroll
            for (int ai = 0; ai < 2; ++ai)
#pragma unroll
            for (int mh = 0; mh < 4; ++mh) {
                f32x4 rc[2], rs[2], g[2][2];
#pragma unroll
                for (int bj = 0; bj < 2; ++bj)
#pragma unroll
                    for (int n = 0; n < 2; ++n) g[bj][n] = *(const f32x4*)(gn + dl + 16 * bj + 4 * n);
                { const int row = row0 + ai * HALF + mh * 16; const int t = row & (row < 32768 ? 8191 : 4095); const int pos = axis == 0 ? (t >> 6) : (t & 63);
#pragma unroll
                  for (int n = 0; n < 2; ++n) { rc[n] = *(const f32x4*)(rope + pos * 32 + jb + 4 * n); rs[n] = *(const f32x4*)(rope + pos * 32 + 16 + jb + 4 * n); } }
                asm volatile("" ::: "memory");
                { const int m = mh; const int row = row0 + ai * HALF + m * 16;
                    float ss = 0.f;
#pragma unroll
                    for (int bj = 0; bj < 2; ++bj)
#pragma unroll
                        for (int n = 0; n < 2; ++n) { const f32x4 v = acc[ai][bj][m][n]; ss += (v[0] * v[0] + v[1] * v[1]) + (v[2] * v[2] + v[3] * v[3]); }
                    ss += __shfl_xor(ss, 16); ss += __shfl_xor(ss, 32);
                    const float ri = ri8[ai][m];
                    const float rinv = ri / sqrtf(ss * ri * ri * (1.0f / 64.0f) + 1e-6f);
                    bf16_t* rowp = dst + (size_t)row * pitch + hc + dl; u32x4e w1, w2;
#pragma unroll
                    for (int n = 0; n < 2; ++n) { const f32x4 c = rc[n], s = rs[n];
                        const f32x4 x1 = acc[ai][0][m][n] * rinv * g[0][n], x2 = acc[ai][1][m][n] * rinv * g[1][n];
                        const f32x4 o1 = (x1 * c - x2 * s) * osc, o2 = (x2 * c + x1 * s) * osc;
                        const u32x2 p1 = pack4(o1), p2 = pack4(o2); w1[2 * n] = p1.x; w1[2 * n + 1] = p1.y; w2[2 * n] = p2.x; w2[2 * n + 1] = p2.y; }
                    *(u32x4e*)rowp = w1; *(u32x4e*)(rowp + 16) = w2; }
                asm volatile("" ::: "memory");
            }
        } else {
            const float osc = kind == 3 ? c2 : 1.0f;
#pragma unroll
            for (int ai = 0; ai < 2; ++ai)
#pragma unroll
                for (int m = 0; m < 4; ++m) { const int row = row0 + ai * HALF + m * 16; bf16_t* rowp = dst + (size_t)row * pitch + hc + dl; const float sc = osc * ri8[ai][m];
#pragma unroll
                    for (int bj = 0; bj < 2; ++bj) { u32x4e w;
#pragma unroll
                        for (int n = 0; n < 2; ++n) { const u32x2 p = pack4(acc[ai][bj][m][n] * sc); w[2 * n] = p.x; w[2 * n + 1] = p.y; }
                        *(u32x4e*)(rowp + 16 * bj) = w; } }
        }
    }
};

struct EpiFinal {
    static constexpr bool PERM = true, AFTER_DRAIN = false;
    float* out; unsigned char* ws; const float* gfin;
    static constexpr unsigned XL = 131072 + 512;
    __device__ __forceinline__ void operator()(f32x4 (&acc)[2][2][4][2], const Unit& u, int wr, int wc, int fr, int fq) const {
        int row0 = u.pm * BM + wr * 64 + fr, col0 = u.pn * BM + wc * 32 + 8 * fq, tid = (wr * 4 + wc) * 64 + fq * 16 + fr, rl0 = wr * 64 + fr; const int wid = wr * 4 + wc;
        asm volatile("" : "+v"(row0), "+v"(col0), "+v"(tid), "+v"(rl0));
        PG8_LAS float* const P = (PG8_LAS float*)(size_t)XL; PG8_LAS float* const S = (PG8_LAS float*)(size_t)(XL + 4096);
        float* const slots = (float*)(ws + WS_SSQ); unsigned* const cnt = (unsigned*)ws + 16384 + 64 * u.pm;
#pragma unroll
        for (int ai = 0; ai < 2; ++ai)
#pragma unroll
            for (int m = 0; m < 4; ++m) { const float* bp = out + (size_t)(row0 + ai * HALF + m * 16) * 1024 + col0;
                const f32x4 p00 = *(const f32x4*)(bp), p01 = *(const f32x4*)(bp + 4), p10 = *(const f32x4*)(bp + HALF), p11 = *(const f32x4*)(bp + HALF + 4);
                acc[ai][0][m][0] = p00 + acc[ai][0][m][0] * 0.5f; acc[ai][0][m][1] = p01 + acc[ai][0][m][1] * 0.5f; acc[ai][1][m][0] = p10 + acc[ai][1][m][0] * 0.5f; acc[ai][1][m][1] = p11 + acc[ai][1][m][1] * 0.5f;
                float ss = 0.f;
#pragma unroll
                for (int bj = 0; bj < 2; ++bj)
#pragma unroll
                    for (int n = 0; n < 2; ++n) { const f32x4 o = acc[ai][bj][m][n]; ss += (o[0] * o[0] + o[1] * o[1]) + (o[2] * o[2] + o[3] * o[3]); }
                ss += __shfl_xor(ss, 16); ss += __shfl_xor(ss, 32);
                if (fq == 0) P[(ai * HALF + m * 16 + rl0) * 4 + wc] = ss;
                asm volatile("" ::: "memory"); }
        asm volatile("s_waitcnt lgkmcnt(0)" ::: "memory"); __builtin_amdgcn_s_barrier(); asm volatile("" ::: "memory");
        if (tid < 256) { const float t = (P[tid * 4 + 0] + P[tid * 4 + 1]) + (P[tid * 4 + 2] + P[tid * 4 + 3]);
            __hip_atomic_store(slots + (size_t)(u.pm * BM + tid) * 16 + u.pn, t, __ATOMIC_RELAXED, __HIP_MEMORY_SCOPE_AGENT); }
        asm volatile("s_waitcnt vmcnt(0)" ::: "memory");
        if (tid < 256 && (tid & 63) == 0) __hip_atomic_fetch_add(cnt, 1u, __ATOMIC_RELAXED, __HIP_MEMORY_SCOPE_AGENT);
        if (wid == 0) { unsigned sp = 0u;
            while ((unsigned)__builtin_amdgcn_readfirstlane((int)__hip_atomic_load(cnt, __ATOMIC_RELAXED, __HIP_MEMORY_SCOPE_AGENT)) < 16u) { __builtin_amdgcn_s_sleep(2); if (++sp > (1u << 22)) break; }
            __builtin_amdgcn_fence(__ATOMIC_ACQUIRE, "agent"); asm volatile("s_waitcnt vmcnt(0)" ::: "memory"); }
        asm volatile("s_waitcnt lgkmcnt(0)" ::: "memory"); __builtin_amdgcn_s_barrier(); asm volatile("" ::: "memory");
        if (tid < 256) { const float* sl = slots + (size_t)(u.pm * BM + tid) * 16;
            const float a = __hip_atomic_load(sl + 0, __ATOMIC_RELAXED, __HIP_MEMORY_SCOPE_AGENT), b = __hip_atomic_load(sl + 1, __ATOMIC_RELAXED, __HIP_MEMORY_SCOPE_AGENT),
                        c = __hip_atomic_load(sl + 2, __ATOMIC_RELAXED, __HIP_MEMORY_SCOPE_AGENT), d = __hip_atomic_load(sl + 3, __ATOMIC_RELAXED, __HIP_MEMORY_SCOPE_AGENT);
            S[tid] = 1.0f / sqrtf(((a + b) + (c + d)) * (1.0f / 1024.0f) + 1e-6f); }
        asm volatile("s_waitcnt lgkmcnt(0)" ::: "memory"); __builtin_amdgcn_s_barrier(); asm volatile("" ::: "memory");
#pragma unroll
        for (int ai = 0; ai < 2; ++ai)
#pragma unroll
            for (int m = 0; m < 4; ++m) { const int rl = ai * HALF + m * 16 + rl0; const float ri = S[rl]; float* rowp = out + (size_t)(u.pm * BM + rl) * 1024 + col0; const float* gp = gfin + col0;
                const f32x4 g00 = *(const f32x4*)(gp), g01 = *(const f32x4*)(gp + 4), g10 = *(const f32x4*)(gp + HALF), g11 = *(const f32x4*)(gp + HALF + 4);
                *(f32x4*)(rowp) = acc[ai][0][m][0] * ri * g00; *(f32x4*)(rowp + 4) = acc[ai][0][m][1] * ri * g01; *(f32x4*)(rowp + HALF) = acc[ai][1][m][0] * ri * g10; *(f32x4*)(rowp + HALF + 4) = acc[ai][1][m][1] * ri * g11;
                asm volatile("" ::: "memory"); }
    }
};

template <class Epi, class Sched, bool ALIGN_EPI = false, bool SP2 = false>
__device__ __forceinline__ void gemm_phase(PG8_LAS unsigned char* lds, const Gemm g, const Sched& S, const Epi& E) {
    const int tid = threadIdx.x, wid = __builtin_amdgcn_readfirstlane(tid >> 6), lane = tid & 63, wr = wid >> 2, wc = wid & 3, fr = lane & 15, fq = lane >> 4;
    const int K = g.K, nt = K / BK;
    unsigned voffA[2], voffB[2];
#pragma unroll
    for (int i = 0; i < 2; ++i) { int R, C; stage_rc(tid * 16 + i * 8192, R, C); const int Rb = Epi::PERM ? ((R & ~31) + perm32(R & 31)) : R;
        voffA[i] = (unsigned)(R * K + C) * 2u; voffB[i] = (unsigned)(Rb * K + C) * 2u; }
    const size_t kstep = (size_t)(BK * 2);
    const size_t hstep = (size_t)HALF * K * 2;
    const size_t tstep = 2 * hstep;
    const unsigned ldsw = (unsigned)wid * 1024u;
    const int aoff = lds_byte(wr * 64 + fr, fq * 8), boff = lds_byte(wc * 32 + fr, fq * 8);
#define PG8_SA(b, h) (((b) * 2 + (h)) * HTB)
#define PG8_SB(b, h) ((4 + (b) * 2 + (h)) * HTB)
#define PG8_STAGE(bufoff, gbase, voff) do { _Pragma("unroll") for (int _i = 0; _i < 2; ++_i) \
        __builtin_amdgcn_global_load_lds((const unsigned*)((const char*)(gbase) + (voff)[_i]), (PG8_LAS unsigned*)(lds + (bufoff) + ldsw + _i * 8192), 16, 0, 0); } while (0)
#define PG8_LDA(dst, b, h) do { _Pragma("unroll") for (int m = 0; m < 4; ++m) _Pragma("unroll") for (int k = 0; k < 2; ++k) dst[m][k] = *(const PG8_LAS bf16x8*)(lds + PG8_SA(b, h) + aoff + m * 2048 + k * 1024); } while (0)
#define PG8_LDB(dst, b, h) do { _Pragma("unroll") for (int n = 0; n < 2; ++n) _Pragma("unroll") for (int k = 0; k < 2; ++k) dst[n][k] = *(const PG8_LAS bf16x8*)(lds + PG8_SB(b, h) + boff + n * 2048 + k * 1024); } while (0)
#define PG8_MMA(ai, bj, At, Bt) do { __builtin_amdgcn_s_setprio(1); _Pragma("unroll") for (int m = 0; m < 4; ++m) _Pragma("unroll") for (int n = 0; n < 2; ++n) _Pragma("unroll") for (int k = 0; k < 2; ++k) \
        acc[ai][bj][m][n] = __builtin_amdgcn_mfma_f32_16x16x32_bf16(Bt[n][k], At[m][k], acc[ai][bj][m][n], 0, 0, 0); __builtin_amdgcn_s_setprio(0); } while (0)
#define PG8_WAIT_V(n) asm volatile("s_waitcnt vmcnt(" #n ")" ::: "memory")
#define PG8_WAIT_L(n) asm volatile("s_waitcnt lgkmcnt(" #n ")" ::: "memory")
#define PG8_BAR __builtin_amdgcn_s_barrier()
#define PG8_SCHED __builtin_amdgcn_sched_barrier(0)
    Unit cur, nxt; int ui = 0;
    if (!S.next(0, cur)) return;
    f32x4 acc[2][2][4][2];
#pragma unroll
    for (int a = 0; a < 2; ++a)
#pragma unroll
        for (int b = 0; b < 2; ++b)
#pragma unroll
            for (int m = 0; m < 4; ++m)
#pragma unroll
                for (int n = 0; n < 2; ++n) acc[a][b][m][n] = (f32x4){0.f, 0.f, 0.f, 0.f};
    bf16x8 At[4][2], B0[2][2], B1[2][2];
    const char* cA = (const char*)g.A + (size_t)cur.pm * tstep; const char* cB = (const char*)g.Bt + (size_t)cur.pn * tstep;
    S.a_ready(cur);
    if constexpr (SP2) {
        PG8_STAGE(PG8_SB(0, 0), cB, voffB); PG8_STAGE(PG8_SB(0, 1), cB + hstep, voffB); PG8_STAGE(PG8_SA(0, 0), cA, voffA); PG8_STAGE(PG8_SA(0, 1), cA + hstep, voffA);
        if (wr == 1) PG8_BAR;
        PG8_WAIT_V(2); PG8_BAR;
        PG8_STAGE(PG8_SB(1, 0), cB + kstep, voffB); PG8_STAGE(PG8_SA(1, 0), cA + kstep, voffA); PG8_STAGE(PG8_SB(1, 1), cB + hstep + kstep, voffB);
        PG8_WAIT_V(6); PG8_BAR;
    } else {
        PG8_STAGE(PG8_SB(0, 0), cB, voffB); PG8_STAGE(PG8_SA(0, 0), cA, voffA); PG8_STAGE(PG8_SB(0, 1), cB + hstep, voffB); PG8_STAGE(PG8_SA(0, 1), cA + hstep, voffA);
        if (wr == 1) PG8_BAR;
        PG8_WAIT_V(4); PG8_BAR;
        PG8_STAGE(PG8_SB(1, 0), cB + kstep, voffB); PG8_STAGE(PG8_SA(1, 0), cA + kstep, voffA); PG8_STAGE(PG8_SB(1, 1), cB + hstep + kstep, voffB);
        PG8_WAIT_V(6); PG8_BAR;
    }
    for (;;) {
        const bool has_next = S.next(ui + 1, nxt);
        const char* nA = has_next ? (const char*)g.A + (size_t)nxt.pm * tstep : cA; const char* nB = has_next ? (const char*)g.Bt + (size_t)nxt.pn * tstep : cB;
        for (int t = 0; t < nt; t += 2) {
            const bool last = (t == nt - 2);
            const char* a1 = cA + (size_t)(t + 1) * kstep;
            const char* a2 = last ? nA : cA + (size_t)(t + 2) * kstep; const char* b2 = last ? nB : cB + (size_t)(t + 2) * kstep;
            const char* a3 = a2 + kstep; const char* b3 = b2 + kstep;
            if (last && has_next) S.a_ready(nxt);
            if constexpr (SP2) {
            PG8_LDB(B0, 0, 0); PG8_LDB(B1, 0, 1); PG8_SCHED; PG8_LDA(At, 0, 0); PG8_STAGE(PG8_SA(1, 1), a1 + hstep, voffA);
            PG8_WAIT_V(8); PG8_WAIT_L(0); PG8_BAR; PG8_MMA(0, 0, At, B0); PG8_MMA(0, 1, At, B1); PG8_BAR; PG8_SCHED;
            PG8_LDA(At, 0, 1); PG8_STAGE(PG8_SB(0, 0), b2, voffB); PG8_STAGE(PG8_SB(0, 1), b2 + hstep, voffB); PG8_STAGE(PG8_SA(0, 0), a2, voffA);
            PG8_WAIT_V(8); PG8_WAIT_L(0); PG8_BAR; PG8_MMA(1, 0, At, B0); PG8_MMA(1, 1, At, B1); PG8_BAR; PG8_SCHED;
            PG8_LDB(B0, 1, 0); PG8_LDB(B1, 1, 1); PG8_SCHED; PG8_LDA(At, 1, 0); PG8_STAGE(PG8_SA(0, 1), a2 + hstep, voffA);
            PG8_WAIT_V(8); PG8_WAIT_L(0); PG8_BAR; PG8_MMA(0, 0, At, B0); PG8_MMA(0, 1, At, B1); PG8_BAR; PG8_SCHED;
            PG8_LDA(At, 1, 1); PG8_STAGE(PG8_SB(1, 0), b3, voffB); PG8_STAGE(PG8_SB(1, 1), b3 + hstep, voffB); PG8_STAGE(PG8_SA(1, 0), a3, voffA);
            PG8_WAIT_V(8); PG8_WAIT_L(0); PG8_BAR; PG8_MMA(1, 0, At, B0); PG8_MMA(1, 1, At, B1); PG8_BAR; PG8_SCHED;
            } else {
            PG8_LDB(B0, 0, 0); PG8_SCHED; PG8_LDA(At, 0, 0); PG8_STAGE(PG8_SA(1, 1), a1 + hstep, voffA);
            PG8_WAIT_L(8); PG8_BAR; PG8_WAIT_L(0); PG8_MMA(0, 0, At, B0); PG8_BAR; PG8_SCHED;
            PG8_LDB(B1, 0, 1); PG8_STAGE(PG8_SB(0, 0), b2, voffB);
            PG8_BAR; PG8_WAIT_L(0); PG8_MMA(0, 1, At, B1); PG8_BAR;
            PG8_LDA(At, 0, 1); PG8_STAGE(PG8_SA(0, 0), a2, voffA);
            PG8_BAR; PG8_WAIT_L(0); PG8_MMA(1, 0, At, B0); PG8_BAR; PG8_SCHED;
            PG8_STAGE(PG8_SB(0, 1), b2 + hstep, voffB);
            PG8_WAIT_V(6); PG8_BAR; PG8_MMA(1, 1, At, B1); PG8_BAR;
            PG8_LDB(B0, 1, 0); PG8_SCHED; PG8_LDA(At, 1, 0); PG8_STAGE(PG8_SA(0, 1), a2 + hstep, voffA);
            PG8_WAIT_L(8); PG8_BAR; PG8_WAIT_L(0); PG8_MMA(0, 0, At, B0); PG8_BAR; PG8_SCHED;
            PG8_LDB(B1, 1, 1); PG8_STAGE(PG8_SB(1, 0), b3, voffB);
            PG8_BAR; PG8_WAIT_L(0); PG8_MMA(0, 1, At, B1); PG8_BAR;
            PG8_LDA(At, 1, 1); PG8_STAGE(PG8_SA(1, 0), a3, voffA);
            PG8_BAR; PG8_WAIT_L(0); PG8_MMA(1, 0, At, B0); PG8_BAR; PG8_SCHED;
            PG8_STAGE(PG8_SB(1, 1), b3 + hstep, voffB);
            PG8_WAIT_V(6); PG8_BAR; PG8_MMA(1, 1, At, B1); PG8_BAR;
            }
        }
        if constexpr (ALIGN_EPI) { if (wr == 0) PG8_BAR; }
        if constexpr (!Epi::AFTER_DRAIN) { E(acc, cur, wr, wc, fr, fq); S.done(cur); }
        if (!has_next) break;
#pragma unroll
        for (int a = 0; a < 2; ++a)
#pragma unroll
            for (int b = 0; b < 2; ++b)
#pragma unroll
                for (int m = 0; m < 4; ++m)
#pragma unroll
                    for (int n = 0; n < 2; ++n) acc[a][b][m][n] = (f32x4){0.f, 0.f, 0.f, 0.f};
        cur = nxt; cA = nA; cB = nB; ++ui;
        if constexpr (ALIGN_EPI) { if (wr == 1) PG8_BAR; }
    }
    PG8_WAIT_V(0);
    if constexpr (!ALIGN_EPI) { if (wr == 0) PG8_BAR; }
    PG8_BAR;
    if constexpr (Epi::AFTER_DRAIN) { E.fused(acc, cur, wr, wc, fr, fq, lds, wid, lane); S.done(cur); }
#undef PG8_SA
#undef PG8_SB
#undef PG8_STAGE
#undef PG8_LDA
#undef PG8_LDB
#undef PG8_MMA
#undef PG8_WAIT_V
#undef PG8_WAIT_L
#undef PG8_BAR
#undef PG8_SCHED
}
}
namespace attn_body {
using bf16=__hip_bfloat16;
using bf16x8=__attribute__((ext_vector_type(8)))short;
using s16x4=__attribute__((ext_vector_type(4)))short;
using f32x16=__attribute__((ext_vector_type(16)))float;
using u32x4=__attribute__((ext_vector_type(4)))unsigned;
constexpr int D=64,QP=512,KP=128;
constexpr int NW=8,QBLK=32,QB=QBLK*NW,KVBLK=64;
constexpr int ATTN_UNIT_ROWS=QB;
__device__ __forceinline__ int crow(int r,int hi){return (r&3)+8*(r>>2)+4*hi;}
#define SBAR() __builtin_amdgcn_sched_barrier(0)
constexpr int NSLOT=3, SLOTB=8192;
constexpr int LDS_K=0, LDS_V=NSLOT*SLOTB, LDS_WS=2*NSLOT*SLOTB, LDS_OST=LDS_WS+NW*64*4, LDS_BYTES=LDS_OST+NW*4096;
constexpr float C2=0.125f*1.4426950408889634f;
__device__ __forceinline__ void glds16(const void*gsrc,unsigned lds_dst){unsigned keep;
  asm volatile("s_mov_b32 %0, m0\n\ts_mov_b32 m0, %2\n\ts_nop 0\n\tglobal_load_lds_dwordx4 %1, off\n\ts_mov_b32 m0, %0":"=&s"(keep):"v"(gsrc),"s"(lds_dst):"memory");}
__device__ __forceinline__ float max3f(float a,float b,float c){float r;asm("v_max3_f32 %0, %1, %2, %3":"=v"(r):"v"(a),"v"(b),"v"(c));return r;}
__device__ __forceinline__ float max2f(float a,float b){float r;asm("v_max_f32_e32 %0, %1, %2":"=v"(r):"v"(a),"v"(b));return r;}
__device__ __forceinline__ float fadd_s(float a,float b){float r;asm("v_add_f32_e32 %0, %1, %2":"=v"(r):"v"(a),"v"(b));return r;}
__device__ __forceinline__ float fsub_s(float a,float b){float r;asm("v_sub_f32_e32 %0, %1, %2":"=v"(r):"v"(a),"v"(b));return r;}
typedef float f32x2_t __attribute__((ext_vector_type(2))); typedef __bf16 bf16x2_t __attribute__((ext_vector_type(2)));
__device__ __forceinline__ unsigned cvtpk_s(float lo,float hi){f32x2_t v={lo,hi};bf16x2_t b=__builtin_convertvector(v,bf16x2_t);return __builtin_bit_cast(unsigned,b);}
#define WAIT_BAR(N) asm volatile("s_waitcnt vmcnt(" #N ") lgkmcnt(0)\n\ts_barrier":::"memory")

__device__ __forceinline__ void qkt(f32x16&p0,f32x16&p1,const char*Kslot,const bf16x8*qr,const f32x16&negm,int r32,int hi){
  const char*kb=Kslot+hi*1024+r32*16;
  #pragma unroll
  for(int d0=0;d0<4;++d0){
    const bf16x8 b0=*reinterpret_cast<const bf16x8*>(kb+d0*2048);
    const bf16x8 b1=*reinterpret_cast<const bf16x8*>(kb+d0*2048+512);
    if(d0==0){p0=__builtin_amdgcn_mfma_f32_32x32x16_bf16(b0,qr[0],negm,0,0,0);p1=__builtin_amdgcn_mfma_f32_32x32x16_bf16(b1,qr[0],negm,0,0,0);}
    else{p0=__builtin_amdgcn_mfma_f32_32x32x16_bf16(b0,qr[d0],p0,0,0,0);p1=__builtin_amdgcn_mfma_f32_32x32x16_bf16(b1,qr[d0],p1,0,0,0);}}
}
typedef __attribute__((address_space(3))) const char* lds_cptr;
typedef short v4i16_t __attribute__((ext_vector_type(4)));
__device__ __forceinline__ void kload8(bf16x8*kf,lds_cptr kp){
  kf[0]=*(const __attribute__((address_space(3))) bf16x8*)(kp);      kf[1]=*(const __attribute__((address_space(3))) bf16x8*)(kp+512);
  kf[2]=*(const __attribute__((address_space(3))) bf16x8*)(kp+2048); kf[3]=*(const __attribute__((address_space(3))) bf16x8*)(kp+2560);
  kf[4]=*(const __attribute__((address_space(3))) bf16x8*)(kp+4096); kf[5]=*(const __attribute__((address_space(3))) bf16x8*)(kp+4608);
  kf[6]=*(const __attribute__((address_space(3))) bf16x8*)(kp+6144); kf[7]=*(const __attribute__((address_space(3))) bf16x8*)(kp+6656);
}
__device__ __forceinline__ void kload2(bf16x8*kf,lds_cptr kp,int j){ kf[2*j]=*(const __attribute__((address_space(3))) bf16x8*)(kp+j*2048); kf[2*j+1]=*(const __attribute__((address_space(3))) bf16x8*)(kp+j*2048+512); }
__device__ __forceinline__ s16x4 vtr(lds_cptr p){ return __builtin_bit_cast(s16x4,__builtin_amdgcn_ds_read_tr16_b64_v4i16((__attribute__((address_space(3))) v4i16_t*)p)); }
__device__ __forceinline__ float rowmax(const f32x16&p0,const f32x16&p1){
  float a=max3f(p0[0],p0[1],p1[0]),b=max3f(p0[2],p0[3],p1[1]);a=max3f(a,p1[2],p1[3]);
  #pragma unroll
  for(int r=4;r<16;r+=4){a=max3f(a,p0[r],p0[r+1]);b=max3f(b,p0[r+2],p0[r+3]);a=max3f(a,p1[r],p1[r+1]);b=max3f(b,p1[r+2],p1[r+3]);}
  const float m=max2f(a,b);
  auto rr=__builtin_amdgcn_permlane32_swap(__float_as_uint(m),__float_as_uint(m),false,false);
  return max2f(__uint_as_float(rr[0]),__uint_as_float(rr[1]));
}
__device__ __forceinline__ void pv(f32x16*o,int vb,bf16x8 pa0,bf16x8 pa1,bf16x8 pa2,bf16x8 pa3){
  #pragma unroll
  for(int d0=0;d0<2;++d0){s16x4 lo[4],hi[4];
    #pragma unroll
    for(int ks=0;ks<4;++ks){
      asm volatile("ds_read_b64_tr_b16 %0,%1 offset:%c2":"=&v"(lo[ks]):"v"(vb),"i"(d0*4096+ks*1024):"memory");
      asm volatile("ds_read_b64_tr_b16 %0,%1 offset:%c2":"=&v"(hi[ks]):"v"(vb),"i"(d0*4096+ks*1024+512):"memory");}
    asm volatile("s_waitcnt lgkmcnt(0)":::"memory");SBAR();
    #define PK(k) (bf16x8){lo[k][0],lo[k][1],lo[k][2],lo[k][3],hi[k][0],hi[k][1],hi[k][2],hi[k][3]}
    o[d0]=__builtin_amdgcn_mfma_f32_32x32x16_bf16(pa0,PK(0),o[d0],0,0,0);
    o[d0]=__builtin_amdgcn_mfma_f32_32x32x16_bf16(pa1,PK(1),o[d0],0,0,0);
    o[d0]=__builtin_amdgcn_mfma_f32_32x32x16_bf16(pa2,PK(2),o[d0],0,0,0);
    o[d0]=__builtin_amdgcn_mfma_f32_32x32x16_bf16(pa3,PK(3),o[d0],0,0,0);
    #undef PK
  }
}

#ifndef ATTN_STORE16
#define ATTN_STORE16(p,v) (*(u32x4*)(p)=(v))
#endif
typedef __attribute__((address_space(3))) const float* lds_cfptr;
__device__ __forceinline__ void biasmask(f32x16&p0,f32x16&p1,lds_cfptr tb){
  #pragma unroll
  for(int r=0;r<16;++r){p0[r]+=tb[(r&3)+8*(r>>2)];p1[r]+=tb[(r&3)+8*(r>>2)+32];}
}
template<int MODE,int THRL> __device__ __forceinline__ void attn_unit(long qrow0,long krow0,int NT,int relb,const bf16*Qh,const bf16*__restrict__ Kh,const bf16*__restrict__ Vh,bf16*Oh,lds_cfptr tbl,float sinkl2,char*shm,float sinkl2b=0.f,float rref=0.f){
  const int tid=threadIdx.x,lane=tid&63,r32=lane&31,hi=lane>>5; const int wid=__builtin_amdgcn_readfirstlane(tid>>6);
  const int hw_=(MODE==2)?(wid>>2):0, rw_=(MODE==2)?(wid&3):wid;
  const bf16*Qw=Qh+hw_*64+(qrow0+rw_*QBLK)*QP;
  const bf16*Kt=Kh+krow0*KP,*Vt=Vh+krow0*KP;
  const unsigned lds0=(unsigned)(uintptr_t)shm;
  float*wsf=(float*)(shm+LDS_WS)+wid*64;
  const bf16*ksrc=Kt+(long)lane*KP+wid*8;
  const bf16*vsrc=Vt+(long)(16*(wid&3)+(lane>>2))*KP+(wid>>2)*32+(lane&3)*8;
  const unsigned kdst=lds0+LDS_K+wid*1024, vdst=lds0+LDS_V+wid*1024;
  #define DMA_K(t,slot) glds16(ksrc+(long)(t)*KVBLK*KP,(unsigned)__builtin_amdgcn_readfirstlane(kdst+(slot)))
  #define DMA_V(t,slot) glds16(vsrc+(long)(t)*KVBLK*KP,(unsigned)__builtin_amdgcn_readfirstlane(vdst+(slot)))
  const int vb0=(int)(lds0+LDS_V)+((lane>>4)&1)*32+(lane&3)*8+(4*hi+((lane&15)>>2))*64;
  const char*Kbase=shm+LDS_K; bf16x8 kf[8];
  const lds_cptr shm3=(lds_cptr)shm; const lds_cptr kp0=shm3+LDS_K+hi*1024+r32*16; const lds_cptr vp0=shm3+LDS_V+((lane>>4)&1)*32+(lane&3)*8+(4*hi+((lane&15)>>2))*64;
  DMA_K(0,0);DMA_V(0,0);DMA_K(1,SLOTB);
  bf16x8 qr[4];
  #pragma unroll
  for(int d0=0;d0<4;++d0)qr[d0]=*reinterpret_cast<const bf16x8*>(&Qw[(long)r32*QP+d0*16+hi*8]);
  float mhat=0.f,l_reg=0.f;f32x16 o[2];o[0]=f32x16{};o[1]=f32x16{};f32x16 negm=f32x16{};asm volatile("":"+v"(negm));
  const lds_cfptr tb0=tbl+hw_*768+(relb-(rw_*QBLK+r32)+383+4*hi);
  #define CMASK(P0,P1,t) do{ if(MODE==1||MODE==2) biasmask(P0,P1,tb0+(t)*64); }while(0)
  bool resc=false;
  #define START(P0,P1) do{ const float rm=(MODE==3)?rref:rowmax(P0,P1); resc=false;     \
    { const float dl=(MODE==1||MODE==2)?__builtin_fmaxf(rm,-64.f):rm; mhat=fadd_s(mhat,dl); \
      _Pragma("unroll") for(int r=0;r<16;++r){P0[r]=fsub_s(P0[r],dl);P1[r]=fsub_s(P1[r],dl);} \
      _Pragma("unroll") for(int r=0;r<16;++r)negm[r]=-mhat; asm volatile("":"+v"(negm)); } \
    _Pragma("unroll") for(int r=0;r<16;++r)P0[r]=__builtin_amdgcn_exp2f(P0[r]); }while(0)
  #define RESC() do{ if(resc){ asm volatile("s_waitcnt lgkmcnt(0)":::"memory"); \
      _Pragma("unroll") for(int d_=0;d_<2;++d_) _Pragma("unroll") for(int r=0;r<16;++r)o[d_][r]*=wsf[crow(r,hi)]; } }while(0)
  f32x16 pA0,pA1,pB0,pB1;
  int sl_prev=0,sl_cur=0,sl_next=SLOTB;
  #define ROT() do{sl_prev=sl_cur;sl_cur=sl_next;sl_next=(sl_next==(NSLOT-1)*SLOTB)?0:sl_next+SLOTB;}while(0)
  DMA_K(2,2*SLOTB);
  WAIT_BAR(3);
  qkt(pA0,pA1,Kbase,qr,negm,r32,hi);asm volatile("s_nop 15\n\ts_nop 7":"+v"(pA0),"+v"(pA1));CMASK(pA0,pA1,0);
  START(pA0,pA1);
  _Pragma("unroll") for(int r=0;r<16;++r)pA1[r]=__builtin_amdgcn_exp2f(pA1[r]);
  WAIT_BAR(0);
  DMA_K(3,0);DMA_V(1,SLOTB);
  ROT();
  kload8(kf,kp0+sl_cur);
  WAIT_BAR(2);
  s16x4 vlo[8],vhi[8]; u32x4 pw0,pw1,pw2,pw3;
  #define PKW(P,B) cvtpk_s(P[B],P[B+1])
  #define PAF(k) __builtin_bit_cast(bf16x8,pw##k)
  #define VFR(i) (bf16x8){vlo[i][0],vlo[i][1],vlo[i][2],vlo[i][3],vhi[i][0],vhi[i][1],vhi[i][2],vhi[i][3]}
  #define PIN(x) asm volatile("":"+v"(x))
  #define MX3(a,b,c) __builtin_fmaxf(__builtin_fmaxf((a),(b)),(c))
  #define GAPA(MF,A0,A1,A2,A3,W0,W1,PW) do{ MF; sacc+=A0; sacc+=A1; sacc+=A2; sacc+=A3; PIN(sacc); W0; W1; PIN(PW); SBAR(); }while(0)
  #define EX(v) __builtin_amdgcn_exp2f(v)
  #define GAPB(MF,X,B) do{ MF; X[B]=EX(X[B]); X[B+1]=EX(X[B+1]); X[B+2]=EX(X[B+2]); X[B+3]=EX(X[B+3]); PIN(X); SBAR(); }while(0)
  #define VRD(i) do{ vlo[i]=vtr(vp_+(((i)>>2)*4096+((i)&3)*1024)); vhi[i]=vtr(vp_+(((i)>>2)*4096+((i)&3)*1024+512)); }while(0)
  #define KRD(G,j) do{ if(G){ kload2(kf,kp0+sl_next,j); SBAR(); } }while(0)
  #define STEP(C0,C1,P0,P1,t,GK,GV,GL) do{ SBAR(); \
    const lds_cptr vp_=vp0+sl_prev; \
    VRD(0); SBAR(); float sacc=(P0[0]+P0[1]); \
    GAPA(C0=__builtin_amdgcn_mfma_f32_32x32x16_bf16(kf[0],qr[0],negm,0,0,0), P0[2],P0[3],P0[4],P0[5],     pw0[0]=PKW(P0,0), pw0[1]=PKW(P0,2), pw0); \
    VRD(4); SBAR(); GAPA(C1=__builtin_amdgcn_mfma_f32_32x32x16_bf16(kf[1],qr[0],negm,0,0,0), P0[6],P0[7],P0[8],P0[9],     pw0[2]=PKW(P0,4), pw0[3]=PKW(P0,6), pw0); \
    VRD(1); SBAR(); GAPA(C0=__builtin_amdgcn_mfma_f32_32x32x16_bf16(kf[2],qr[1],C0,0,0,0),   P0[10],P0[11],P0[12],P0[13], pw1[0]=PKW(P0,8), pw1[1]=PKW(P0,10), pw1); \
    VRD(5); SBAR(); GAPA(C1=__builtin_amdgcn_mfma_f32_32x32x16_bf16(kf[3],qr[1],C1,0,0,0),   P0[14],P0[15],P1[0],P1[1],   pw1[2]=PKW(P0,12),pw1[3]=PKW(P0,14), pw1); \
    VRD(2); SBAR(); GAPA(C0=__builtin_amdgcn_mfma_f32_32x32x16_bf16(kf[4],qr[2],C0,0,0,0),   P1[2],P1[3],P1[4],P1[5],     pw2[0]=PKW(P1,0), pw2[1]=PKW(P1,2), pw2); \
    VRD(6); SBAR(); GAPA(C1=__builtin_amdgcn_mfma_f32_32x32x16_bf16(kf[5],qr[2],C1,0,0,0),   P1[6],P1[7],P1[8],P1[9],     pw2[2]=PKW(P1,4), pw2[3]=PKW(P1,6), pw2); \
    VRD(3); SBAR(); GAPA(C0=__builtin_amdgcn_mfma_f32_32x32x16_bf16(kf[6],qr[3],C0,0,0,0),   P1[10],P1[11],P1[12],P1[13], pw3[0]=PKW(P1,8), pw3[1]=PKW(P1,10), pw3); \
    VRD(7); SBAR(); GAPA(C1=__builtin_amdgcn_mfma_f32_32x32x16_bf16(kf[7],qr[3],C1,0,0,0),   P1[14],P1[15],0.f,0.f,       pw3[2]=PKW(P1,12),pw3[3]=PKW(P1,14), pw3); \
    l_reg+=sacc; \
    if(GK){DMA_K((t)+3,sl_cur);} if(GV){DMA_V((t)+1,sl_next);} \
    CMASK(C0,C1,t); \
    if(MODE!=3){ float a=MX3(C0[0],C0[1],C1[0]),b=MX3(C0[2],C0[3],C1[1]); a=MX3(a,C1[2],C1[3]); \
      _Pragma("unroll") for(int r=4;r<16;r+=4){a=MX3(a,C0[r],C0[r+1]);b=MX3(b,C0[r+2],C0[r+3]);a=MX3(a,C1[r],C1[r+1]);b=MX3(b,C1[r+2],C1[r+3]);} \
      float rm=__builtin_fmaxf(a,b); { auto rr=__builtin_amdgcn_permlane32_swap(__float_as_uint(rm),__float_as_uint(rm),false,false); rm=__builtin_fmaxf(__uint_as_float(rr[0]),__uint_as_float(rr[1])); } \
      resc=false; \
      if(__builtin_expect(__any(rm>(float)THRL),0)){ const float dl=__builtin_fmaxf(rm,0.f); mhat+=dl; \
        _Pragma("unroll") for(int r=0;r<16;++r){C0[r]-=dl;C1[r]-=dl;} \
        _Pragma("unroll") for(int r=0;r<16;++r)negm[r]=-mhat; asm volatile("":"+v"(negm)); \
        const float f=__builtin_amdgcn_exp2f(-dl); l_reg*=f; if(hi==0)wsf[r32]=f; resc=true; } } \
    SBAR(); \
    GAPB(o[0]=__builtin_amdgcn_mfma_f32_32x32x16_bf16(PAF(0),VFR(0),o[0],0,0,0), C0,0); \
    GAPB(o[1]=__builtin_amdgcn_mfma_f32_32x32x16_bf16(PAF(0),VFR(4),o[1],0,0,0), C0,4); \
    KRD(GL,0); GAPB(o[0]=__builtin_amdgcn_mfma_f32_32x32x16_bf16(PAF(1),VFR(1),o[0],0,0,0), C0,8); \
    KRD(GL,1); GAPB(o[1]=__builtin_amdgcn_mfma_f32_32x32x16_bf16(PAF(1),VFR(5),o[1],0,0,0), C0,12); \
    KRD(GL,2); GAPB(o[0]=__builtin_amdgcn_mfma_f32_32x32x16_bf16(PAF(2),VFR(2),o[0],0,0,0), C1,0); \
    KRD(GL,3); GAPB(o[1]=__builtin_amdgcn_mfma_f32_32x32x16_bf16(PAF(2),VFR(6),o[1],0,0,0), C1,4); \
    GAPB(o[0]=__builtin_amdgcn_mfma_f32_32x32x16_bf16(PAF(3),VFR(3),o[0],0,0,0), C1,8); \
    GAPB(o[1]=__builtin_amdgcn_mfma_f32_32x32x16_bf16(PAF(3),VFR(7),o[1],0,0,0), C1,12); \
    }while(0)
  int t=1;
  for(;t+5<NT;t+=2){
    STEP(pB0,pB1,pA0,pA1,t,true,true,true);     WAIT_BAR(2); RESC(); ROT();
    STEP(pA0,pA1,pB0,pB1,t+1,true,true,true);   WAIT_BAR(2); RESC(); ROT();
  }
  #define ENDW(tt) do{ if((tt)+3<NT){WAIT_BAR(2);} else if((tt)+2<NT){WAIT_BAR(1);} else {WAIT_BAR(0);} }while(0)
  for(;t+1<NT;t+=2){
    STEP(pB0,pB1,pA0,pA1,t,(t+3<NT),(t+1<NT),(t+1<NT));       ENDW(t);   RESC(); ROT();
    STEP(pA0,pA1,pB0,pB1,t+1,(t+4<NT),(t+2<NT),(t+2<NT));     ENDW(t+1); RESC(); ROT();
  }
  STEP(pB0,pB1,pA0,pA1,NT-1,false,false,false); RESC();
  { float sacc=pB0[0]+pB0[1]; _Pragma("unroll") for(int r=2;r<16;++r)sacc+=pB0[r]; _Pragma("unroll") for(int r=0;r<16;++r)sacc+=pB1[r]; l_reg+=sacc;
    pw0=(u32x4){PKW(pB0,0),PKW(pB0,2),PKW(pB0,4),PKW(pB0,6)};pw1=(u32x4){PKW(pB0,8),PKW(pB0,10),PKW(pB0,12),PKW(pB0,14)};pw2=(u32x4){PKW(pB1,0),PKW(pB1,2),PKW(pB1,4),PKW(pB1,6)};pw3=(u32x4){PKW(pB1,8),PKW(pB1,10),PKW(pB1,12),PKW(pB1,14)};
    SBAR(); pv(o,vb0+sl_cur,PAF(0),PAF(1),PAF(2),PAF(3)); }
  #undef PKW
  #undef PAF
  #undef VFR
  #undef PIN
  #undef MX3
  #undef GAPA
  #undef GAPB
  #undef EX
  #undef VRD
  #undef KRD
  #undef STEP
  #undef ENDW
  {auto rr=__builtin_amdgcn_permlane32_swap(__float_as_uint(l_reg),__float_as_uint(l_reg),false,false);l_reg=__uint_as_float(rr[0])+__uint_as_float(rr[1]);}
  if(MODE==1||MODE==2)l_reg+=__builtin_amdgcn_exp2f(((MODE==2&&hw_)?sinkl2b:sinkl2)-mhat);
  if(hi==0)wsf[32+r32]=l_reg;asm volatile("s_waitcnt lgkmcnt(0)":::"memory");
  float rli[16];
  #pragma unroll
  for(int r=0;r<16;++r)rli[r]=__builtin_amdgcn_rcpf(wsf[32+crow(r,hi)]);
  bf16*Ow=Oh+hw_*64+(qrow0+rw_*QBLK)*QP;
  { bf16*stg=(bf16*)(shm+LDS_OST)+wid*2048;
    #pragma unroll
    for(int r=0;r<16;++r){const int orow=crow(r,hi);
      #pragma unroll
      for(int d0=0;d0<2;++d0)stg[orow*64+d0*32+r32]=__float2bfloat16(o[d0][r]*rli[r]);}
    asm volatile("s_waitcnt lgkmcnt(0)":::"memory");
    #pragma unroll
    for(int i=0;i<4;++i){const int row=i*8+(lane>>3),ch=lane&7; const u32x4 v=*(const u32x4*)(stg+row*64+ch*8); ATTN_STORE16(Ow+(long)row*QP+ch*8,v);} }
  asm volatile("s_waitcnt lgkmcnt(0)\n\ts_barrier":::"memory");
  #undef DMA_K
  #undef DMA_V
  #undef CMASK
  #undef START
  #undef RESC
  #undef ROT
}
constexpr int ATTN_LDS_BYTES=LDS_BYTES;
#undef SBAR
#undef WAIT_BAR
}

constexpr int NWAVES = 8;
constexpr int N_PHASES = 12;
#ifndef STAGGER
#define STAGGER 8
#endif
#ifndef GEMM_ALIGN
#define GEMM_ALIGN true
#endif
#ifndef GEMM_SP2
#define GEMM_SP2 true
#endif
constexpr int RING_BYTES = 131072, LDS_BYTES = 147456;
constexpr int ATT_TBL_OFF = 86016;
static_assert(attn_body::ATTN_LDS_BYTES <= ATT_TBL_OFF && ATT_TBL_OFF + 8 * 768 * 4 <= RING_BYTES, "lds map");

#define GAS __attribute__((address_space(1)))
#define LAS __attribute__((address_space(3)))
typedef unsigned short bf16;
typedef unsigned v4u __attribute__((ext_vector_type(4)));
typedef unsigned v2u __attribute__((ext_vector_type(2)));
typedef float f32x4 __attribute__((ext_vector_type(4)));
#define LDS_WAIT() asm volatile("s_waitcnt lgkmcnt(0)" ::: "memory")
__device__ __forceinline__ unsigned f2bf(float f) { unsigned u = __builtin_bit_cast(unsigned, f); return (u + 0x7fffu + ((u >> 16) & 1u)) >> 16; }
__device__ __forceinline__ unsigned pk2(float lo, float hi) { return f2bf(lo) | (f2bf(hi) << 16); }
__device__ __forceinline__ float wave_sum(float v) {
#pragma unroll
    for (int o = 1; o < 64; o <<= 1) v += __shfl_xor(v, o);
    return v;
}
__device__ __forceinline__ int rowmap(int mode, int j) {
    if (mode == 1) { const int b = j >= DFF ? 1 : 0, jj = j - b * DFF; return 256 * (jj >> 7) + 128 * b + (jj & 127); }
    if (mode == 2 && j < 1536) { const int L = j & 255; return (j & ~255) + 128 * ((L >> 4) & 1) + 32 * (L >> 6) + 16 * ((L >> 5) & 1) + (L & 15); }
    return j;
}
__device__ __forceinline__ void p0_transpose_item(const float* W, int K, int N, bf16* WT, int mode, LAS float* scr, int item, int lane, const float* gk = nullptr) {
    const int nblk = N / 32, kb = item / nblk, nb = item % nblk, k0 = 64 * kb, n0 = 32 * nb;
#pragma unroll 8
    for (int i = 0; i < 32; ++i) { const int kk = 2 * i + (lane >> 5); scr[kk * 33 + (lane & 31)] = W[(size_t)(k0 + kk) * N + n0 + (lane & 31)] * (gk ? gk[k0 + kk] : 1.0f); }
    LDS_WAIT(); asm volatile("" ::: "memory");
    const int c = lane & 7;
#pragma unroll
    for (int j = 0; j < 4; ++j) { const int n = (lane >> 3) + 8 * j; const LAS float* s = scr + (8 * c) * 33 + n;
        v4u o; o.x = pk2(s[0 * 33], s[1 * 33]); o.y = pk2(s[2 * 33], s[3 * 33]); o.z = pk2(s[4 * 33], s[5 * 33]); o.w = pk2(s[6 * 33], s[7 * 33]);
        *(GAS v4u*)(WT + (size_t)rowmap(mode, n0 + n) * K + k0 + 8 * c) = o; }
    LDS_WAIT(); asm volatile("" ::: "memory");
}
__device__ __forceinline__ void rms_row_to_bf16(const float* xrow, const float* g, bf16* orow, int lane) {
    const GAS f32x4* xr = (const GAS f32x4*)xrow + lane; const GAS f32x4* gr = (const GAS f32x4*)g + lane;
    f32x4 v[4]; float s = 0.f;
#pragma unroll
    for (int j = 0; j < 4; ++j) { v[j] = xr[64 * j]; s += (v[j].x * v[j].x + v[j].y * v[j].y) + (v[j].z * v[j].z + v[j].w * v[j].w); }
    const float rinv = 1.f / sqrtf(wave_sum(s) * (1.f / DM) + EPS);
    GAS v2u* o8 = (GAS v2u*)orow + lane;
#pragma unroll
    for (int j = 0; j < 4; ++j) { const f32x4 gg = gr[64 * j]; v2u o; o.x = pk2(v[j].x * rinv * gg.x, v[j].y * rinv * gg.y); o.y = pk2(v[j].z * rinv * gg.z, v[j].w * rinv * gg.w); o8[64 * j] = o; }
}
__device__ __forceinline__ void rms_row2_to_bf16(const float* x0, const float* x1, const float* g, bf16* o0, bf16* o1, int lane) {
    const GAS f32x4* xr0 = (const GAS f32x4*)x0 + lane; const GAS f32x4* xr1 = (const GAS f32x4*)x1 + lane; const GAS f32x4* gr = (const GAS f32x4*)g + lane;
    f32x4 v[4], w[4]; float s = 0.f, t = 0.f;
#pragma unroll
    for (int j = 0; j < 4; ++j) { v[j] = xr0[64 * j]; w[j] = xr1[64 * j]; }
#pragma unroll
    for (int j = 0; j < 4; ++j) { s += (v[j].x * v[j].x + v[j].y * v[j].y) + (v[j].z * v[j].z + v[j].w * v[j].w); t += (w[j].x * w[j].x + w[j].y * w[j].y) + (w[j].z * w[j].z + w[j].w * w[j].w); }
    const float ri = 1.f / sqrtf(wave_sum(s) * (1.f / DM) + EPS), rj = 1.f / sqrtf(wave_sum(t) * (1.f / DM) + EPS);
    GAS v2u* p0 = (GAS v2u*)o0 + lane; GAS v2u* p1 = (GAS v2u*)o1 + lane;
#pragma unroll
    for (int j = 0; j < 4; ++j) { const f32x4 gg = gr[64 * j]; v2u o; o.x = pk2(v[j].x * ri * gg.x, v[j].y * ri * gg.y); o.y = pk2(v[j].z * ri * gg.z, v[j].w * ri * gg.w); p0[64 * j] = o;
        o.x = pk2(w[j].x * rj * gg.x, w[j].y * rj * gg.y); o.y = pk2(w[j].z * rj * gg.z, w[j].w * rj * gg.w); p1[64 * j] = o; }
}
__device__ __forceinline__ void rms_row2_inplace(float* x0, float* x1, const float* g, int lane) {
    GAS f32x4* xr0 = (GAS f32x4*)x0 + lane; GAS f32x4* xr1 = (GAS f32x4*)x1 + lane; const GAS f32x4* gr = (const GAS f32x4*)g + lane;
    f32x4 v[4], w[4]; float s = 0.f, t = 0.f;
#pragma unroll
    for (int j = 0; j < 4; ++j) { v[j] = xr0[64 * j]; w[j] = xr1[64 * j]; }
#pragma unroll
    for (int j = 0; j < 4; ++j) { s += (v[j].x * v[j].x + v[j].y * v[j].y) + (v[j].z * v[j].z + v[j].w * v[j].w); t += (w[j].x * w[j].x + w[j].y * w[j].y) + (w[j].z * w[j].z + w[j].w * w[j].w); }
    const float ri = 1.f / sqrtf(wave_sum(s) * (1.f / DM) + EPS), rj = 1.f / sqrtf(wave_sum(t) * (1.f / DM) + EPS);
#pragma unroll
    for (int j = 0; j < 4; ++j) { const f32x4 gg = gr[64 * j]; xr0[64 * j] = v[j] * ri * gg; xr1[64 * j] = w[j] * rj * gg; }
}
__device__ __forceinline__ void rms_row_inplace(float* xrow, const float* g, int lane) {
    GAS f32x4* xr = (GAS f32x4*)xrow + lane; const GAS f32x4* gr = (const GAS f32x4*)g + lane;
    f32x4 v[4]; float s = 0.f;
#pragma unroll
    for (int j = 0; j < 4; ++j) { v[j] = xr[64 * j]; s += (v[j].x * v[j].x + v[j].y * v[j].y) + (v[j].z * v[j].z + v[j].w * v[j].w); }
    const float rinv = 1.f / sqrtf(wave_sum(s) * (1.f / DM) + EPS);
#pragma unroll
    for (int j = 0; j < 4; ++j) xr[64 * j] = v[j] * rinv * gr[64 * j];
}
__device__ __forceinline__ void rope_entry(int pos, int j, float& c, float& s) {
    const float inv = __builtin_amdgcn_exp2f(-0.8304820237218405f * (float)j), ang = (float)pos * inv;
    const float k = rintf(ang * 0.6366197723675814f);
    float r = fmaf(-k, 1.57079637050628662109375f, ang); r = fmaf(-k, -4.37113900018624283e-8f, r);
    const float r2 = r * r;
    const float sp = r + r * r2 * (-1.6666666666666666e-1f + r2 * (8.333333333333333e-3f + r2 * (-1.984126984126984e-4f + r2 * 2.7557319223985893e-6f)));
    const float cp = 1.0f + r2 * (-0.5f + r2 * (4.1666666666666664e-2f + r2 * (-1.3888888888888889e-3f + r2 * (2.48015873015873e-5f + r2 * -2.755731922398589e-7f))));
    const int q = ((int)k) & 3;
    s = (q == 0) ? sp : (q == 1) ? cp : (q == 2) ? -sp : -cp;
    c = (q == 0) ? cp : (q == 1) ? -sp : (q == 2) ? -cp : sp;
}
__device__ __forceinline__ int t5_bucket(int rel) {
    const int n = rel < 0 ? -rel : rel; int v;
    if (n < 8) v = n; else { const int lg = 31 - __builtin_clz((unsigned)(n * n) >> 6); v = 8 + lg; v = v > 15 ? 15 : v; }
    return (rel > 0 ? 16 : 0) + v;
}


#define XB_TMO      128
#define XB_XCNT(j)  (256  + 64 * (j))
#define XB_XSUB(j)  (1280 + 64 * (j))
#define XB_XGEN(j)  (2304 + 64 * (j))
#define XB_TOP      3328
#define XB_TOPGEN   3392
#define XCD_BAR_WORDS 3456
#define XB_SPIN_CAP (1u << 18)

__device__ __forceinline__ unsigned xb_ld(unsigned* p)              { return __hip_atomic_load(p, __ATOMIC_RELAXED, __HIP_MEMORY_SCOPE_AGENT); }
__device__ __forceinline__ unsigned xb_add(unsigned* p, unsigned v) { return __hip_atomic_fetch_add(p, v, __ATOMIC_RELAXED, __HIP_MEMORY_SCOPE_AGENT); }
__device__ __forceinline__ unsigned xb_xcc_id() { return (unsigned)__builtin_amdgcn_s_getreg((3 << 11) | 20) & 0xFu; }
#define XB_SPIN(cond, bar) do { unsigned _sp = 0; while (cond) { __builtin_amdgcn_s_sleep(1); \
    if ((++_sp & 255u) == 0u) { if (xb_ld(&(bar)[XB_TMO])) break; if (_sp > XB_SPIN_CAP) { atomicAdd(&(bar)[XB_TMO], 1u); break; } } } } while (0)

struct XcdBarrier {
    unsigned* bar; unsigned x;
    volatile LAS unsigned* st;
};

__device__ __forceinline__ XcdBarrier xcd_barrier_post(unsigned* bar, volatile LAS unsigned* st) {
    XcdBarrier b; b.bar = bar; b.x = xb_xcc_id(); b.st = st;
    if (threadIdx.x == 0) (void)xb_add(&bar[XB_XCNT(b.x)], 1u);
    return b;
}
__device__ __forceinline__ void xcd_barrier_complete(unsigned* bar, unsigned x, unsigned& nloc, unsigned& nx) {
    const unsigned G = gridDim.x * gridDim.y * gridDim.z;
    unsigned sum, cnt, mine, sp = 0u;
    for (;;) {
        sum = 0u; cnt = 0u; mine = 0u;
#pragma unroll
        for (unsigned j = 0; j < 16; ++j) { const unsigned c = xb_ld(&bar[XB_XCNT(j)]); sum += c; cnt += (c > 0u) ? 1u : 0u; mine = (j == x) ? c : mine; }
        if (sum == G) break;
        __builtin_amdgcn_s_sleep(1);
        if ((++sp & 255u) == 0u) { if (xb_ld(&bar[XB_TMO])) break; if (sp > XB_SPIN_CAP) { atomicAdd(&bar[XB_TMO], 1u); break; } }
    }
    nloc = mine > 0u ? mine : 1u; nx = cnt > 0u ? cnt : 1u;
}

__device__ __forceinline__ void xcd_barrier(const XcdBarrier& b) {
    asm volatile("s_waitcnt vmcnt(0)" ::: "memory");
    __syncthreads();
    if (threadIdx.x == 0) {
        unsigned* bar = b.bar;
        __builtin_amdgcn_s_waitcnt(0);
        unsigned nloc = b.st[0], nx = b.st[1];
        if (nloc == 0u) { xcd_barrier_complete(bar, b.x, nloc, nx); b.st[0] = nloc; b.st[1] = nx; }
        const unsigned old = xb_add(&bar[XB_XSUB(b.x)], 1u);
        const unsigned gen = old / nloc;
        if (old + 1u == (gen + 1u) * nloc) {
            __builtin_amdgcn_fence(__ATOMIC_RELEASE, "agent");
            asm volatile("s_waitcnt vmcnt(0)" ::: "memory");
            const unsigned og = xb_add(&bar[XB_TOP], 1u);
            const unsigned tg = og / nx;
            if (og + 1u == (tg + 1u) * nx) xb_add(&bar[XB_TOPGEN], 1u);
            else XB_SPIN(xb_ld(&bar[XB_TOPGEN]) == tg, bar);
            __builtin_amdgcn_fence(__ATOMIC_ACQUIRE, "agent");
            xb_add(&bar[XB_XGEN(b.x)], 1u);
            asm volatile("s_waitcnt vmcnt(0)" ::: "memory");
        } else {
            XB_SPIN(xb_ld(&bar[XB_XGEN(b.x)]) == gen, bar);
            __builtin_amdgcn_fence(__ATOMIC_ACQUIRE, "agent");
            asm volatile("s_waitcnt vmcnt(0)" ::: "memory");
        }
    }
    __syncthreads();
}
struct Args { const float* in[18]; float* out; unsigned char* ws; int ph_lo, ph_hi; };
__global__ void __launch_bounds__(NWAVES * 64, 2) mega_fwd(Args args) {
    extern __shared__ __attribute__((aligned(16))) unsigned char lds[];
    LAS unsigned char* const ldsl = (LAS unsigned char*)lds;
    const int tid = threadIdx.x, lane = tid & 63, wave = __builtin_amdgcn_readfirstlane(tid >> 6);
    const int G = gridDim.x; const int bx = blockIdx.x; const int vcu = (G % 8 == 0) ? (bx % 8) * (G / 8) + bx / 8 : bx;
    cg::grid_group grid = cg::this_grid();
    volatile LAS unsigned* const MISC = (volatile LAS unsigned*)(ldsl + RING_BYTES + 320);
    if (tid < 32) MISC[tid] = 0u;
    __syncthreads();
    if (args.ph_hi < 0) grid.sync();
    XcdBarrier xbar = xcd_barrier_post((unsigned*)args.ws + 4096, MISC + 8);
    unsigned char* const ws = args.ws;
    const float* xp = args.in[0]; const float* xs = args.in[1];
    float* const out = args.out;
    bf16* const W1in = (bf16*)(ws + WS_W1IN); bf16* const W1out = (bf16*)(ws + WS_W1OUT); bf16* const Win = (bf16*)(ws + WS_WIN); bf16* const Wa = (bf16*)(ws + WS_WA);
    bf16* const Wb = (bf16*)(ws + WS_WB); bf16* const Wo = (bf16*)(ws + WS_WO); bf16* const W2in = (bf16*)(ws + WS_W2IN); bf16* const W2out = (bf16*)(ws + WS_W2OUT);
    float* const rope = (float*)(ws + WS_ROPE);
    bf16* const XN = (bf16*)(ws + WS_XN); bf16* const ACT = (bf16*)(ws + WS_ACT);
    bf16* const QA = (bf16*)(ws + WS_QA); bf16* const QB = (bf16*)(ws + WS_QB); bf16* const KA = (bf16*)(ws + WS_KA); bf16* const VA = (bf16*)(ws + WS_VA);
    bf16* const KB = (bf16*)(ws + WS_KB); bf16* const VB = (bf16*)(ws + WS_VB); bf16* const GA = (bf16*)(ws + WS_GA); bf16* const GB = (bf16*)(ws + WS_GB);
    float* const SSQ = (float*)(ws + WS_SSQ);
    bf16* const MG = (bf16*)(ws + WS_GA);
    const int lo = args.ph_lo, hi = args.ph_hi;
    const int gw = vcu * NWAVES + wave, NGW = G * NWAVES;
#define IN(k) (lo <= (k) && (k) < hi)
#define SEAM(k) do { xcd_barrier(xbar); } while (0)

    if (IN(0)) {
        LAS float* scr = (LAS float*)(ldsl + wave * 16384);
        constexpr int I_IN = (DM / 64) * (2 * DFF / 32), I_OUT = (DFF / 64) * (DM / 32), I_MIX = (DM / 64) * (NIN / 32), I_BR = (512 / 64) * (DM / 32), I_O = (DM / 64) * (DM / 32);
        constexpr int NITEMS = 2 * I_IN + 2 * I_OUT + I_MIX + 2 * I_BR + I_O;
        for (int it = gw; it < NITEMS; it += NGW) {
            int r = it;
            if (r < I_IN)  { p0_transpose_item(args.in[3], DM, 2 * DFF, W1in, 1, scr, r, lane); continue; } r -= I_IN;
            if (r < I_IN)  { p0_transpose_item(args.in[14], DM, 2 * DFF, W2in, 1, scr, r, lane, args.in[13]); continue; } r -= I_IN;
            if (r < I_OUT) { p0_transpose_item(args.in[4], DFF, DM, W1out, 0, scr, r, lane); continue; } r -= I_OUT;
            if (r < I_OUT) { p0_transpose_item(args.in[15], DFF, DM, W2out, 0, scr, r, lane); continue; } r -= I_OUT;
            if (r < I_MIX) { p0_transpose_item(args.in[6], DM, NIN, Win, 2, scr, r, lane, args.in[5]); continue; } r -= I_MIX;
            if (r < I_BR)  { p0_transpose_item(args.in[10], 512, DM, Wa, 0, scr, r, lane); continue; } r -= I_BR;
            if (r < I_BR)  { p0_transpose_item(args.in[11], 512, DM, Wb, 0, scr, r, lane); continue; } r -= I_BR;
            p0_transpose_item(args.in[12], DM, DM, Wo, 0, scr, r, lane);
        }
        { const int gt = vcu * (NWAVES * 64) + tid; if (gt < 128 * 16) { float c, s; rope_entry(gt >> 4, gt & 15, c, s); rope[(gt >> 4) * 32 + (gt & 15)] = c; rope[(gt >> 4) * 32 + 16 + (gt & 15)] = s; } }
        for (int m = gw; m < M / 2; m += NGW) { const int m1 = m + M / 2;
            rms_row2_to_bf16(xp + (size_t)m * DM, m1 < MP ? xp + (size_t)m1 * DM : xs + (size_t)(m1 - MP) * DM, args.in[2], XN + (size_t)m * DM, XN + (size_t)m1 * DM, lane); }
    }
    SEAM(0);
    if (IN(1)) {
        pg8::Gemm g{XN, W1in, M, 2 * DFF, DM}; pg8::StaticOrder S; S.init(M, 2 * DFF, G, bx);
        pg8::EpiSwiglu E{ws, false};
        pg8::gemm_phase<pg8::EpiSwiglu, pg8::StaticOrder, GEMM_ALIGN, GEMM_SP2>(ldsl, g, S, E);
    }
    SEAM(1);
    if (IN(2)) {
        pg8::Gemm g{ACT, W1out, M, DM, DFF}; pg8::StaticOrder S; S.init(M, DM, G, bx);
        pg8::EpiResid<true> E{xp, xs - (size_t)MP * DM, MP, out, 0.5f, ws};
        pg8::gemm_phase<pg8::EpiResid<true>, pg8::StaticOrder, false, GEMM_SP2>(ldsl, g, S, E);
    }
    SEAM(2);
    if (IN(4)) {
        pg8::Gemm g{XN, Win, M, NIN, DM}; pg8::StaticOrder S; S.init(M, NIN, G, bx);
        pg8::EpiMix E{ws, args.in[7], args.in[8]};
        pg8::gemm_phase<pg8::EpiMix, pg8::StaticOrder, GEMM_ALIGN, GEMM_SP2>(ldsl, g, S, E);
    }
    SEAM(4);
    if (IN(5)) {
        LAS float* tbl = (LAS float*)(ldsl + ATT_TBL_OFF);
        for (int i = tid; i < 8 * 768; i += NWAVES * 64) { const int h = i / 768, rel = (i % 768) - 383; const int ar = rel < 0 ? -rel : rel;
            tbl[i] = (ar <= 128) ? args.in[16][t5_bucket(rel) * 8 + h] * LOG2E : -1e30f; }
        __syncthreads();
        typedef attn_body::bf16 abf;
        float rref; { float gq = fabsf(args.in[7][lane]), gk = fabsf(args.in[8][lane]);
#pragma unroll
            for (int o = 1; o < 64; o <<= 1) { gq = fmaxf(gq, __shfl_xor(gq, o)); gk = fmaxf(gk, __shfl_xor(gk, o)); }
            rref = 1.02f * 8.0f * gq * gk * LOG2E; }
        const bool fixedref = rref < 60.0f;
        { const int per = (1024 + G - 1) / G;
          for (int i = 0; i < per; ++i) { const int u = vcu * per + i; if (u >= 1024) break; const int bh = u >> 5, qb = u & 31, b = bh >> 3, h = bh & 7;
            const long r0 = (long)b * TP;
            if (fixedref) attn_body::attn_unit<3, 8>(r0 + qb * 256, r0, TP / 64, 0, (const abf*)QA + h * 64, (const abf*)KA + (h >> 2) * 64, (const abf*)VA + (h >> 2) * 64, (abf*)QA + h * 64, tbl, 0.f, (char*)lds, 0.f, rref);
            else attn_body::attn_unit<0, 8>(r0 + qb * 256, r0, TP / 64, 0, (const abf*)QA + h * 64, (const abf*)KA + (h >> 2) * 64, (const abf*)VA + (h >> 2) * 64, (abf*)QA + h * 64, tbl, 0.f, (char*)lds); } }
        { const int per = (512 + G - 1) / G;
          for (int i = 0; i < per; ++i) { const int u = vcu * per + i; if (u >= 512) break; const int bh = u >> 4, qb = u & 15, b = bh >> 3, h = bh & 7;
            const long r0 = (long)MP + (long)b * TS;
            if (fixedref) attn_body::attn_unit<3, 8>(r0 + qb * 256, r0, TS / 64, 0, (const abf*)QA + h * 64, (const abf*)KA + (h >> 2) * 64, (const abf*)VA + (h >> 2) * 64, (abf*)QA + h * 64, tbl, 0.f, (char*)lds, 0.f, rref);
            else attn_body::attn_unit<0, 8>(r0 + qb * 256, r0, TS / 64, 0, (const abf*)QA + h * 64, (const abf*)KA + (h >> 2) * 64, (const abf*)VA + (h >> 2) * 64, (abf*)QA + h * 64, tbl, 0.f, (char*)lds); } }
        { const int per = (1536 + G - 1) / G;
          for (int i = 0; i < per; ++i) { const int u = vcu * per + i; if (u >= 1536) break; const int rb = u >> 2, h = (u & 3) * 2;
            long r0; int q0, T;
            if (rb < MP / 128) { r0 = (long)(rb / (TP / 128)) * TP; q0 = (rb % (TP / 128)) * 128; T = TP; } else { const int r2 = rb - MP / 128; r0 = (long)MP + (long)(r2 / (TS / 128)) * TS; q0 = (r2 % (TS / 128)) * 128; T = TS; }
            const int k0 = q0 >= 128 ? q0 - 128 : 0, k1 = q0 + 256 <= T ? q0 + 256 : T;
            attn_body::attn_unit<2, 8>(r0 + q0, r0 + k0, (k1 - k0) / 64, k0 - q0, (const abf*)QB + h * 64, (const abf*)KB + (h >> 2) * 64, (const abf*)VB + (h >> 2) * 64, (abf*)QB + h * 64, tbl + h * 768, args.in[9][h] * LOG2E, (char*)lds, args.in[9][h + 1] * LOG2E); } }
    }
    SEAM(5);
    if (IN(6)) {
        { pg8::Gemm g{QA, Wa, M, DM, 512}; pg8::StaticOrder S; S.init(M, DM, G, bx); pg8::EpiGate<false> E{ws};
          pg8::gemm_phase<pg8::EpiGate<false>, pg8::StaticOrder, false, GEMM_SP2>(ldsl, g, S, E); }
        { pg8::Gemm g{QB, Wb, M, DM, 512}; pg8::StaticOrder S; S.init(M, DM, G, bx); pg8::EpiGate<true> E{ws};
          pg8::gemm_phase<pg8::EpiGate<true>, pg8::StaticOrder, false, GEMM_SP2>(ldsl, g, S, E); }
    }
    SEAM(6);
    if (IN(7)) {
        pg8::Gemm g{MG, Wo, M, DM, DM}; pg8::StaticOrder S; S.init(M, DM, G, bx);
        pg8::EpiResid<true> E{out, out, MP, out, 1.0f, ws};
        pg8::gemm_phase<pg8::EpiResid<true>, pg8::StaticOrder, false, GEMM_SP2>(ldsl, g, S, E);
    }
    SEAM(7);
    if (IN(9)) {
        pg8::Gemm g{XN, W2in, M, 2 * DFF, DM}; pg8::StaticOrder S; S.init(M, 2 * DFF, G, bx);
        pg8::EpiSwiglu E{ws, true};
        pg8::gemm_phase<pg8::EpiSwiglu, pg8::StaticOrder, GEMM_ALIGN, GEMM_SP2>(ldsl, g, S, E);
    }
    SEAM(9);
    if (IN(10)) {
        pg8::Gemm g{ACT, W2out, M, DM, DFF}; pg8::StaticOrder S; S.init(M, DM, G, bx);
        pg8::EpiFinal E{out, ws, args.in[17]};
        pg8::gemm_phase<pg8::EpiFinal, pg8::StaticOrder, true, GEMM_SP2>(ldsl, g, S, E);
    }
#undef IN
#undef SEAM
}

extern "C" void kernel_launch(void* const* d_in, const int* in_sizes, int n_in, void* d_out, int out_size, void* d_ws, size_t ws_size, hipStream_t stream) {
    static int grid = 0;
    if (grid == 0) {
        if (n_in != 18 || in_sizes[0] != MP * DM || in_sizes[1] != MS * DM || out_size != M * DM || ws_size < WS_END) {
            fprintf(stderr, "kernel_launch: shape/workspace mismatch (n_in %d, in0 %d, in1 %d, out %d, ws %zu); nothing launched\n", n_in, n_in > 0 ? in_sizes[0] : -1, n_in > 1 ? in_sizes[1] : -1, out_size, ws_size); grid = -1; return; }
        int dev = 0, cus = 0, per_cu = 0;
        if (hipGetDevice(&dev) != hipSuccess || hipDeviceGetAttribute(&cus, hipDeviceAttributeMultiprocessorCount, dev) != hipSuccess) { fprintf(stderr, "kernel_launch: device query failed\n"); grid = -1; return; }
        if (hipFuncSetAttribute((const void*)mega_fwd, hipFuncAttributeMaxDynamicSharedMemorySize, LDS_BYTES) != hipSuccess) { fprintf(stderr, "kernel_launch: hipFuncSetAttribute failed\n"); grid = -1; return; }
        if (hipOccupancyMaxActiveBlocksPerMultiprocessor(&per_cu, (const void*)mega_fwd, NWAVES * 64, LDS_BYTES) != hipSuccess || per_cu < 1) { fprintf(stderr, "kernel_launch: occupancy query says %d\n", per_cu); per_cu = 1; }
        (void)hipGetLastError();
        grid = cus;
    }
    if (grid < 0) return;
    if (hipMemsetAsync(d_ws, 0, 131072, stream) != hipSuccess) { fprintf(stderr, "kernel_launch: hipMemsetAsync of the barrier words failed\n"); return; }
    Args a{};
    for (int i = 0; i < 18; ++i) a.in[i] = (const float*)d_in[i];
    a.out = (float*)d_out; a.ws = (unsigned char*)d_ws;
    a.ph_lo = 0; a.ph_hi = N_PHASES;
    void* kargs[] = {&a};
    const hipError_t e = hipLaunchCooperativeKernel((const void*)mega_fwd, dim3(grid), dim3(NWAVES * 64), kargs, LDS_BYTES, stream);
    if (e != hipSuccess) fprintf(stderr, "kernel_launch: cooperative launch failed: %s (grid %d)\n", hipGetErrorString(e), grid);
}
```

```cpp
#include <hip/hip_runtime.h>
#include <hip/hip_cooperative_groups.h>
#include <hip/hip_bf16.h>
#include <cstdio>
#include <cstdint>
#include <cmath>
namespace cg = cooperative_groups;
constexpr int DM = 1024, DFF = 2816, NIN = 3584, MP = 32768  , MS = 16384  , M = MP + MS;
constexpr int TP = 8192, TS = 4096;
constexpr float EPS = 1e-6f;
constexpr float LOG2E = 1.4426950408889634f;
constexpr float C2 = 0.125f * LOG2E;
constexpr size_t MiB = 1u << 20;
constexpr size_t WS_W1IN = 1 * MiB, WS_W1OUT = 12 * MiB, WS_WIN = 18 * MiB, WS_WA = 25 * MiB, WS_WB = 26 * MiB, WS_WO = 27 * MiB, WS_W2IN = 29 * MiB, WS_W2OUT = 40 * MiB;
constexpr size_t WS_ROPE = 46 * MiB, WS_XN = 48 * MiB, WS_ACT = 144 * MiB;
constexpr size_t WS_QA = 144 * MiB, WS_QB = 192 * MiB, WS_KA = 240 * MiB, WS_VA = 252 * MiB, WS_KB = 264 * MiB, WS_VB = 276 * MiB, WS_GA = 288 * MiB, WS_GB = 384 * MiB, WS_SSQ = 480 * MiB, WS_END = 483 * MiB;
static_assert(WS_ACT + (size_t)M * DFF * 2 <= WS_END && WS_XN + (size_t)M * DM * 2 <= WS_ACT && WS_GB + (size_t)M * DM * 2 <= WS_END, "ws map");
namespace pg8 {
#define PG8_LAS __attribute__((address_space(3)))
typedef unsigned short bf16_t;
typedef short bf16x8 __attribute__((ext_vector_type(8)));
typedef float f32x4 __attribute__((ext_vector_type(4)));
typedef unsigned u32x4 __attribute__((ext_vector_type(4)));
constexpr int BM = 256, BK = 64, HALF = 128, HTB = HALF * BK * 2  , STAGE_BYTES = 8 * HTB, NXCD = 8, WGM = 8;

__host__ __device__ __forceinline__ int lds_byte(int r, int c) { const int st = (r >> 4) * 2 + (c >> 5), rr = r & 15, cc = c & 31, ob = rr * 64 + cc * 2; return st * 1024 + (ob ^ (((ob >> 9) & 1) << 5)); }
__host__ __device__ __forceinline__ void stage_rc(int b, int& R, int& C) { const int st = b / 1024, sb = b % 1024, swz = sb ^ (((sb >> 9) & 1) << 5); R = (st >> 1) * 16 + swz / 64; C = (st & 1) * 32 + (swz % 64) / 2; }
__host__ __device__ __forceinline__ int perm32(int rho) { const int n = rho >> 4, i = rho & 15; return 8 * (i >> 2) + 4 * n + (i & 3); }

struct Unit { int pm, pn; };
struct Gemm { const bf16_t* A; const bf16_t* Bt; int M, N, K; };

struct StaticOrder {
    int nM, nN, nwg, G, c;
    __host__ __device__ void init(int M, int N, int G_, int c_) { nM = M / BM; nN = N / BM; nwg = nM * nN; G = G_; c = c_; }
    __host__ __device__ bool next(int i, Unit& u) const {
        const long L = (long)i * G + c; if (L >= nwg) return false;
        int wgid = (int)L; { const int q = nwg / NXCD, r = nwg % NXCD, xcd = wgid % NXCD, off = wgid / NXCD; wgid = (xcd < r ? xcd * (q + 1) : r * (q + 1) + (xcd - r) * q) + off; }
        const int nig = WGM * nN, gid = wgid / nig, fm = gid * WGM, gsz = (nM - fm) < WGM ? (nM - fm) : WGM;
        u.pm = fm + ((wgid % nig) % gsz); u.pn = (wgid % nig) / gsz; return true;
    }
    __device__ __forceinline__ void a_ready(const Unit&) const {}
    __device__ __forceinline__ void done(const Unit&) const {}
};

typedef float f32x2_c __attribute__((ext_vector_type(2))); typedef __bf16 bf16x2_c __attribute__((ext_vector_type(2)));
__device__ __forceinline__ unsigned cvt_pk_bf16(float lo, float hi) { f32x2_c v = {lo, hi}; bf16x2_c b = __builtin_convertvector(v, bf16x2_c); return __builtin_bit_cast(unsigned, b); }
typedef unsigned u32x2 __attribute__((ext_vector_type(2)));
typedef unsigned u32x4e __attribute__((ext_vector_type(4)));
__device__ __forceinline__ u32x2 pack4(f32x4 v) { u32x2 w; w.x = cvt_pk_bf16(v[0], v[1]); w.y = cvt_pk_bf16(v[2], v[3]); return w; }
__device__ __forceinline__ f32x4 unpack4(u32x2 w) { f32x4 v; v[0] = __uint_as_float(w.x << 16); v[1] = __uint_as_float(w.x & 0xffff0000u); v[2] = __uint_as_float(w.y << 16); v[3] = __uint_as_float(w.y & 0xffff0000u); return v; }
__device__ __forceinline__ float sigmoid_f(float v) { return __builtin_amdgcn_rcpf(1.0f + __builtin_amdgcn_exp2f(-1.4426950408889634f * v)); }

__device__ __forceinline__ void rows_rinv(const float* ssq, int row0, int fq, float (&ri)[2][4]);
struct EpiSwiglu {
    static constexpr bool PERM = true, AFTER_DRAIN = false;
    unsigned char* ws; bool scaled;
    __device__ __forceinline__ void operator()(const f32x4 (&acc)[2][2][4][2], const Unit& u, int wr, int wc, int fr, int fq) const {
        const int row0 = u.pm * BM + wr * 64 + fr, col0 = u.pn * HALF + wc * 32 + 8 * fq;
        float ri[2][4];
        if (scaled) rows_rinv((const float*)(ws + WS_SSQ), row0, fq, ri);
        else {
#pragma unroll
            for (int ai = 0; ai < 2; ++ai)
#pragma unroll
                for (int m = 0; m < 4; ++m) ri[ai][m] = 1.0f; }
#pragma unroll
        for (int ai = 0; ai < 2; ++ai)
#pragma unroll
            for (int m = 0; m < 4; ++m) { const int row = row0 + ai * HALF + m * 16; bf16_t* rowp = (bf16_t*)(ws + WS_ACT) + (size_t)row * DFF + col0; u32x4e w;
#pragma unroll
                for (int n = 0; n < 2; ++n) { const f32x4 a = acc[ai][0][m][n] * ri[ai][m], b = acc[ai][1][m][n] * ri[ai][m]; f32x4 o;
#pragma unroll
                    for (int i = 0; i < 4; ++i) o[i] = a[i] * sigmoid_f(a[i]) * b[i];
                    const u32x2 p = pack4(o); w[2 * n] = p.x; w[2 * n + 1] = p.y; }
                *(u32x4e*)rowp = w; }
    }
};
template <bool NORMOUT> struct EpiResid {
    static constexpr bool PERM = true, AFTER_DRAIN = false;
    const float* base0; const float* base1; int split; float* out; float s; unsigned char* ws;
    __device__ __forceinline__ void operator()(const f32x4 (&acc)[2][2][4][2], const Unit& u, int wr, int wc, int fr, int fq) const {
        const int row0 = u.pm * BM + wr * 64 + fr, col0 = u.pn * BM + wc * 32 + 8 * fq;
        const float* base = (u.pm * BM < split) ? base0 : base1; bf16_t* const xn = (bf16_t*)(ws + WS_XN); float* const ssq = (float*)(ws + WS_SSQ);
#pragma unroll
        for (int ai = 0; ai < 2; ++ai)
#pragma unroll
        for (int mh = 0; mh < 4; mh += 2) {
            f32x4 pre[4][2][2];
#pragma unroll
            for (int m = mh; m < mh + 2; ++m)
#pragma unroll
                for (int bj = 0; bj < 2; ++bj)
#pragma unroll
                    for (int n = 0; n < 2; ++n) pre[m][bj][n] = *(const f32x4*)(base + (size_t)(row0 + ai * HALF + m * 16) * 1024 + col0 + bj * HALF + n * 4);
            asm volatile("" ::: "memory");
#pragma unroll
            for (int m = mh; m < mh + 2; ++m) { const int row = row0 + ai * HALF + m * 16; const size_t off = (size_t)row * 1024 + col0; float ss = 0.f;
#pragma unroll
                for (int bj = 0; bj < 2; ++bj) { u32x4e w;
#pragma unroll
                    for (int n = 0; n < 2; ++n) { const f32x4 o = pre[m][bj][n] + acc[ai][bj][m][n] * s;
                        *(f32x4*)(out + off + bj * HALF + n * 4) = o;
                        if (NORMOUT) { const u32x2 p = pack4(o); w[2 * n] = p.x; w[2 * n + 1] = p.y; ss += (o[0] * o[0] + o[1] * o[1]) + (o[2] * o[2] + o[3] * o[3]); } }
                    if (NORMOUT) *(u32x4e*)(xn + off + bj * HALF) = w; }
                if (NORMOUT) { ss += __shfl_xor(ss, 16); ss += __shfl_xor(ss, 32); if (fq == 0) ssq[(size_t)row * 16 + u.pn * 4 + wc] = ss; } }
            asm volatile("" ::: "memory");
        }
    }
};
__device__ __forceinline__ void rows_rinv(const float* ssq, int row0, int fq, float (&ri)[2][4]) {
    f32x4 p[2][4];
#pragma unroll
    for (int ai = 0; ai < 2; ++ai)
#pragma unroll
        for (int m = 0; m < 4; ++m) p[ai][m] = *(const f32x4*)(ssq + (size_t)(row0 + ai * HALF + m * 16) * 16 + 4 * fq);
#pragma unroll
    for (int ai = 0; ai < 2; ++ai)
#pragma unroll
        for (int m = 0; m < 4; ++m) { float t = (p[ai][m][0] + p[ai][m][1]) + (p[ai][m][2] + p[ai][m][3]); t += __shfl_xor(t, 16); t += __shfl_xor(t, 32);
            ri[ai][m] = 1.0f / sqrtf(t * (1.0f / 1024.0f) + 1e-6f); }
}
template <bool ADD> struct EpiGate {
    static constexpr bool PERM = true, AFTER_DRAIN = false;
    unsigned char* ws;
    __device__ __forceinline__ void operator()(const f32x4 (&acc)[2][2][4][2], const Unit& u, int wr, int wc, int fr, int fq) const {
        const int row0 = u.pm * BM + wr * 64 + fr, col0 = u.pn * BM + wc * 32 + 8 * fq;
        const bf16_t* const G = (const bf16_t*)(ws + (ADD ? WS_GB : WS_GA)); bf16_t* const Mg = (bf16_t*)(ws + WS_GA);
#pragma unroll
        for (int ai = 0; ai < 2; ++ai)
#pragma unroll
        for (int mh = 0; mh < 4; mh += 2) {
            u32x2 pg[4][2][2], pm_[4][2][2];
#pragma unroll
            for (int m = mh; m < mh + 2; ++m)
#pragma unroll
                for (int bj = 0; bj < 2; ++bj)
#pragma unroll
                    for (int n = 0; n < 2; ++n) { const size_t off = (size_t)(row0 + ai * HALF + m * 16) * 1024 + col0 + bj * HALF + n * 4;
                        pg[m][bj][n] = *(const u32x2*)(G + off); if (ADD) pm_[m][bj][n] = *(const u32x2*)(Mg + off); }
            asm volatile("" ::: "memory");
#pragma unroll
            for (int m = mh; m < mh + 2; ++m)
#pragma unroll
                for (int bj = 0; bj < 2; ++bj)
#pragma unroll
                    for (int n = 0; n < 2; ++n) { const size_t off = (size_t)(row0 + ai * HALF + m * 16) * 1024 + col0 + bj * HALF + n * 4;
                        f32x4 o = unpack4(pg[m][bj][n]) * acc[ai][bj][m][n]; if (ADD) o = o + unpack4(pm_[m][bj][n]);
                        *(u32x2*)(Mg + off) = pack4(o); }
            asm volatile("" ::: "memory");
        }
    }
};
struct EpiMix {
    static constexpr bool PERM = true, AFTER_DRAIN = false;
    unsigned char* ws; const float *qn, *kn;
    __device__ __forceinline__ void operator()(const f32x4 (&acc)[2][2][4][2], const Unit& u, int wr, int wc, int fr, int fq) const {
        const int pn = u.pn, row0 = u.pm * BM + wr * 64 + fr; const float c2 = C2;
        const float* const rope = (const float*)(ws + WS_ROPE);
        float ri8[2][4]; rows_rinv((const float*)(ws + WS_SSQ), row0, fq, ri8);
        if (pn >= 6) {
            bf16_t* G = (bf16_t*)(ws + (pn < 10 ? WS_GA : WS_GB)); const int col0 = (pn < 10 ? pn - 6 : pn - 10) * BM + wc * 32 + 8 * fq;
#pragma unroll
            for (int ai = 0; ai < 2; ++ai)
#pragma unroll
                for (int m = 0; m < 4; ++m) { const int row = row0 + ai * HALF + m * 16; bf16_t* rowp = G + (size_t)row * 1024 + col0; const float ri = ri8[ai][m];
#pragma unroll
                    for (int bj = 0; bj < 2; ++bj) { u32x4e w;
#pragma unroll
                        for (int n = 0; n < 2; ++n) { const f32x4 v = acc[ai][bj][m][n] * ri; f32x4 o;
#pragma unroll
                            for (int i = 0; i < 4; ++i) o[i] = sigmoid_f(v[i]);
                            const u32x2 p = pack4(o); w[2 * n] = p.x; w[2 * n + 1] = p.y; }
                        *(u32x4e*)(rowp + bj * HALF) = w; } }
            return;
        }
        int kind, pitch, hc; bf16_t* dst;
        if (pn < 2)       { dst = (bf16_t*)(ws + WS_QA); pitch = 512; hc = (4 * pn + wc) * 64; kind = 0; }
        else if (pn == 2) { pitch = 128; if (wc < 2) { dst = (bf16_t*)(ws + WS_KA); hc = wc * 64; kind = 1; } else { dst = (bf16_t*)(ws + WS_VA); hc = (wc - 2) * 64; kind = 2; } }
        else if (pn < 5)  { dst = (bf16_t*)(ws + WS_QB); pitch = 512; hc = (4 * (pn - 3) + wc) * 64; kind = 3; }
        else              { pitch = 128; kind = 2; if (wc < 2) { dst = (bf16_t*)(ws + WS_KB); hc = wc * 64; } else { dst = (bf16_t*)(ws + WS_VB); hc = (wc - 2) * 64; } }
        const int dl = 32 * (fq >> 1) + 8 * (fq & 1);
        if (kind < 2) {
            const float* gn = kind == 0 ? qn : kn; const float osc = kind == 0 ? c2 : 1.0f; const int axis = fq >> 1, jb = 8 * (fq & 1);
#pragma unroll
            for (int ai = 0; ai < 2; ++ai)
#pragma unroll
            for (int mh = 0; mh < 4; ++mh) {
                f32x4 rc[2], rs[2], g[2][2];
#pragma unroll
                for (int bj = 0; bj < 2; ++bj)
#pragma unroll
                    for (int n = 0; n < 2; ++n) g[bj][n] = *(const f32x4*)(gn + dl + 16 * bj + 4 * n);
                { const int row = row0 + ai * HALF + mh * 16; const int t = row & (row < 32768 ? 8191 : 4095); const int pos = axis == 0 ? (t >> 6) : (t & 63);
#pragma unroll
                  for (int n = 0; n < 2; ++n) { rc[n] = *(const f32x4*)(rope + pos * 32 + jb + 4 * n); rs[n] = *(const f32x4*)(rope + pos * 32 + 16 + jb + 4 * n); } }
                asm volatile("" ::: "memory");
                { const int m = mh; const int row = row0 + ai * HALF + m * 16;
                    float ss = 0.f;
#pragma unroll
                    for (int bj = 0; bj < 2; ++bj)
#pragma unroll
                        for (int n = 0; n < 2; ++n) { const f32x4 v = acc[ai][bj][m][n]; ss += (v[0] * v[0] + v[1] * v[1]) + (v[2] * v[2] + v[3] * v[3]); }
                    ss += __shfl_xor(ss, 16); ss += __shfl_xor(ss, 32);
                    const float ri = ri8[ai][m];
                    const float rinv = ri / sqrtf(ss * ri * ri * (1.0f / 64.0f) + 1e-6f);
                    bf16_t* rowp = dst + (size_t)row * pitch + hc + dl; u32x4e w1, w2;
#pragma unroll
                    for (int n = 0; n < 2; ++n) { const f32x4 c = rc[n], s = rs[n];
                        const f32x4 x1 = acc[ai][0][m][n] * rinv * g[0][n], x2 = acc[ai][1][m][n] * rinv * g[1][n];
                        const f32x4 o1 = (x1 * c - x2 * s) * osc, o2 = (x2 * c + x1 * s) * osc;
                        const u32x2 p1 = pack4(o1), p2 = pack4(o2); w1[2 * n] = p1.x; w1[2 * n + 1] = p1.y; w2[2 * n] = p2.x; w2[2 * n + 1] = p2.y; }
                    *(u32x4e*)rowp = w1; *(u32x4e*)(rowp + 16) = w2; }
                asm volatile("" ::: "memory");
            }
        } else {
            const float osc = kind == 3 ? c2 : 1.0f;
#pragma unroll
            for (int ai = 0; ai < 2; ++ai)
#pragma unroll
                for (int m = 0; m < 4; ++m) { const int row = row0 + ai * HALF + m * 16; bf16_t* rowp = dst + (size_t)row * pitch + hc + dl; const float sc = osc * ri8[ai][m];
#pragma unroll
                    for (int bj = 0; bj < 2; ++bj) { u32x4e w;
#pragma unroll
                        for (int n = 0; n < 2; ++n) { const u32x2 p = pack4(acc[ai][bj][m][n] * sc); w[2 * n] = p.x; w[2 * n + 1] = p.y; }
                        *(u32x4e*)(rowp + 16 * bj) = w; } }
        }
    }
};

struct EpiFinal {
    static constexpr bool PERM = true, AFTER_DRAIN = false;
    float* out; unsigned char* ws; const float* gfin;
    static constexpr unsigned XL = 131072 + 512;
    __device__ __forceinline__ void operator()(f32x4 (&acc)[2][2][4][2], const Unit& u, int wr, int wc, int fr, int fq) const {
        int row0 = u.pm * BM + wr * 64 + fr, col0 = u.pn * BM + wc * 32 + 8 * fq, tid = (wr * 4 + wc) * 64 + fq * 16 + fr, rl0 = wr * 64 + fr; const int wid = wr * 4 + wc;
        asm volatile("" : "+v"(row0), "+v"(col0), "+v"(tid), "+v"(rl0));
        PG8_LAS float* const P = (PG8_LAS float*)(size_t)XL; PG8_LAS float* const S = (PG8_LAS float*)(size_t)(XL + 4096);
        float* const slots = (float*)(ws + WS_SSQ); unsigned* const cnt = (unsigned*)ws + 16384 + 64 * u.pm;
#pragma unroll
        for (int ai = 0; ai < 2; ++ai)
#pragma unroll
            for (int m = 0; m < 4; ++m) { const float* bp = out + (size_t)(row0 + ai * HALF + m * 16) * 1024 + col0;
                const f32x4 p00 = *(const f32x4*)(bp), p01 = *(const f32x4*)(bp + 4), p10 = *(const f32x4*)(bp + HALF), p11 = *(const f32x4*)(bp + HALF + 4);
                acc[ai][0][m][0] = p00 + acc[ai][0][m][0] * 0.5f; acc[ai][0][m][1] = p01 + acc[ai][0][m][1] * 0.5f; acc[ai][1][m][0] = p10 + acc[ai][1][m][0] * 0.5f; acc[ai][1][m][1] = p11 + acc[ai][1][m][1] * 0.5f;
                float ss = 0.f;
#pragma unroll
                for (int bj = 0; bj < 2; ++bj)
#pragma unroll
                    for (int n = 0; n < 2; ++n) { const f32x4 o = acc[ai][bj][m][n]; ss += (o[0] * o[0] + o[1] * o[1]) + (o[2] * o[2] + o[3] * o[3]); }
                ss += __shfl_xor(ss, 16); ss += __shfl_xor(ss, 32);
                if (fq == 0) P[(ai * HALF + m * 16 + rl0) * 4 + wc] = ss;
                asm volatile("" ::: "memory"); }
        asm volatile("s_waitcnt lgkmcnt(0)" ::: "memory"); __builtin_amdgcn_s_barrier(); asm volatile("" ::: "memory");
        if (tid < 256) { const float t = (P[tid * 4 + 0] + P[tid * 4 + 1]) + (P[tid * 4 + 2] + P[tid * 4 + 3]);
            __hip_atomic_store(slots + (size_t)(u.pm * BM + tid) * 16 + u.pn, t, __ATOMIC_RELAXED, __HIP_MEMORY_SCOPE_AGENT); }
        asm volatile("s_waitcnt vmcnt(0)" ::: "memory");
        if (tid < 256 && (tid & 63) == 0) __hip_atomic_fetch_add(cnt, 1u, __ATOMIC_RELAXED, __HIP_MEMORY_SCOPE_AGENT);
        if (wid == 0) { unsigned sp = 0u;
            while ((unsigned)__builtin_amdgcn_readfirstlane((int)__hip_atomic_load(cnt, __ATOMIC_RELAXED, __HIP_MEMORY_SCOPE_AGENT)) < 16u) { __builtin_amdgcn_s_sleep(2); if (++sp > (1u << 22)) break; }
            __builtin_amdgcn_fence(__ATOMIC_ACQUIRE, "agent"); asm volatile("s_waitcnt vmcnt(0)" ::: "memory"); }
        asm volatile("s_waitcnt lgkmcnt(0)" ::: "memory"); __builtin_amdgcn_s_barrier(); asm volatile("" ::: "memory");
        if (tid < 256) { const float* sl = slots + (size_t)(u.pm * BM + tid) * 16;
            const float a = __hip_atomic_load(sl + 0, __ATOMIC_RELAXED, __HIP_MEMORY_SCOPE_AGENT), b = __hip_atomic_load(sl + 1, __ATOMIC_RELAXED, __HIP_MEMORY_SCOPE_AGENT),
                        c = __hip_atomic_load(sl + 2, __ATOMIC_RELAXED, __HIP_MEMORY_SCOPE_AGENT), d = __hip_atomic_load(sl + 3, __ATOMIC_RELAXED, __HIP_MEMORY_SCOPE_AGENT);
            S[tid] = 1.0f / sqrtf(((a + b) + (c + d)) * (1.0f / 1024.0f) + 1e-6f); }
        asm volatile("s_waitcnt lgkmcnt(0)" ::: "memory"); __builtin_amdgcn_s_barrier(); asm volatile("" ::: "memory");
#pragma unroll
        for (int ai = 0; ai < 2; ++ai)
#pragma unroll
            for (int m = 0; m < 4; ++m) { const int rl = ai * HALF + m * 16 + rl0; const float ri = S[rl]; float* rowp = out + (size_t)(u.pm * BM + rl) * 1024 + col0; const float* gp = gfin + col0;
                const f32x4 g00 = *(const f32x4*)(gp), g01 = *(const f32x4*)(gp + 4), g10 = *(const f32x4*)(gp + HALF), g11 = *(const f32x4*)(gp + HALF + 4);
                *(f32x4*)(rowp) = acc[ai][0][m][0] * ri * g00; *(f32x4*)(rowp + 4) = acc[ai][0][m][1] * ri * g01; *(f32x4*)(rowp + HALF) = acc[ai][1][m][0] * ri * g10; *(f32x4*)(rowp + HALF + 4) = acc[ai][1][m][1] * ri * g11;
                asm volatile("" ::: "memory"); }
    }
};

template <class Epi, class Sched, bool ALIGN_EPI = false, bool SP2 = false>
__device__ __forceinline__ void gemm_phase(PG8_LAS unsigned char* lds, const Gemm g, const Sched& S, const Epi& E) {
    const int tid = threadIdx.x, wid = __builtin_amdgcn_readfirstlane(tid >> 6), lane = tid & 63, wr = wid >> 2, wc = wid & 3, fr = lane & 15, fq = lane >> 4;
    const int K = g.K, nt = K / BK;
    unsigned voffA[2], voffB[2];
#pragma unroll
    for (int i = 0; i < 2; ++i) { int R, C; stage_rc(tid * 16 + i * 8192, R, C); const int Rb = Epi::PERM ? ((R & ~31) + perm32(R & 31)) : R;
        voffA[i] = (unsigned)(R * K + C) * 2u; voffB[i] = (unsigned)(Rb * K + C) * 2u; }
    const size_t kstep = (size_t)(BK * 2);
    const size_t hstep = (size_t)HALF * K * 2;
    const size_t tstep = 2 * hstep;
    const unsigned ldsw = (unsigned)wid * 1024u;
    const int aoff = lds_byte(wr * 64 + fr, fq * 8), boff = lds_byte(wc * 32 + fr, fq * 8);
#define PG8_SA(b, h) (((b) * 2 + (h)) * HTB)
#define PG8_SB(b, h) ((4 + (b) * 2 + (h)) * HTB)
#define PG8_STAGE(bufoff, gbase, voff) do { _Pragma("unroll") for (int _i = 0; _i < 2; ++_i) \
        __builtin_amdgcn_global_load_lds((const unsigned*)((const char*)(gbase) + (voff)[_i]), (PG8_LAS unsigned*)(lds + (bufoff) + ldsw + _i * 8192), 16, 0, 0); } while (0)
#define PG8_LDA(dst, b, h) do { _Pragma("unroll") for (int m = 0; m < 4; ++m) _Pragma("unroll") for (int k = 0; k < 2; ++k) dst[m][k] = *(const PG8_LAS bf16x8*)(lds + PG8_SA(b, h) + aoff + m * 2048 + k * 1024); } while (0)
#define PG8_LDB(dst, b, h) do { _Pragma("unroll") for (int n = 0; n < 2; ++n) _Pragma("unroll") for (int k = 0; k < 2; ++k) dst[n][k] = *(const PG8_LAS bf16x8*)(lds + PG8_SB(b, h) + boff + n * 2048 + k * 1024); } while (0)
#define PG8_MMA(ai, bj, At, Bt) do { __builtin_amdgcn_s_setprio(1); _Pragma("unroll") for (int m = 0; m < 4; ++m) _Pragma("unroll") for (int n = 0; n < 2; ++n) _Pragma("unroll") for (int k = 0; k < 2; ++k) \
        acc[ai][bj][m][n] = __builtin_amdgcn_mfma_f32_16x16x32_bf16(Bt[n][k], At[m][k], acc[ai][bj][m][n], 0, 0, 0); __builtin_amdgcn_s_setprio(0); } while (0)
#define PG8_WAIT_V(n) asm volatile("s_waitcnt vmcnt(" #n ")" ::: "memory")
#define PG8_WAIT_L(n) asm volatile("s_waitcnt lgkmcnt(" #n ")" ::: "memory")
#define PG8_BAR __builtin_amdgcn_s_barrier()
#define PG8_SCHED __builtin_amdgcn_sched_barrier(0)
    Unit cur, nxt; int ui = 0;
    if (!S.next(0, cur)) return;
    f32x4 acc[2][2][4][2];
#pragma unroll
    for (int a = 0; a < 2; ++a)
#pragma unroll
        for (int b = 0; b < 2; ++b)
#pragma unroll
            for (int m = 0; m < 4; ++m)
#pragma unroll
                for (int n = 0; n < 2; ++n) acc[a][b][m][n] = (f32x4){0.f, 0.f, 0.f, 0.f};
    bf16x8 At[4][2], B0[2][2], B1[2][2];
    const char* cA = (const char*)g.A + (size_t)cur.pm * tstep; const char* cB = (const char*)g.Bt + (size_t)cur.pn * tstep;
    S.a_ready(cur);
    if constexpr (SP2) {
        PG8_STAGE(PG8_SB(0, 0), cB, voffB); PG8_STAGE(PG8_SB(0, 1), cB + hstep, voffB); PG8_STAGE(PG8_SA(0, 0), cA, voffA); PG8_STAGE(PG8_SA(0, 1), cA + hstep, voffA);
        if (wr == 1) PG8_BAR;
        PG8_WAIT_V(2); PG8_BAR;
        PG8_STAGE(PG8_SB(1, 0), cB + kstep, voffB); PG8_STAGE(PG8_SA(1, 0), cA + kstep, voffA); PG8_STAGE(PG8_SB(1, 1), cB + hstep + kstep, voffB);
        PG8_WAIT_V(6); PG8_BAR;
    } else {
        PG8_STAGE(PG8_SB(0, 0), cB, voffB); PG8_STAGE(PG8_SA(0, 0), cA, voffA); PG8_STAGE(PG8_SB(0, 1), cB + hstep, voffB); PG8_STAGE(PG8_SA(0, 1), cA + hstep, voffA);
        if (wr == 1) PG8_BAR;
        PG8_WAIT_V(4); PG8_BAR;
        PG8_STAGE(PG8_SB(1, 0), cB + kstep, voffB); PG8_STAGE(PG8_SA(1, 0), cA + kstep, voffA); PG8_STAGE(PG8_SB(1, 1), cB + hstep + kstep, voffB);
        PG8_WAIT_V(6); PG8_BAR;
    }
    for (;;) {
        const bool has_next = S.next(ui + 1, nxt);
        const char* nA = has_next ? (const char*)g.A + (size_t)nxt.pm * tstep : cA; const char* nB = has_next ? (const char*)g.Bt + (size_t)nxt.pn * tstep : cB;
        for (int t = 0; t < nt; t += 2) {
            const bool last = (t == nt - 2);
            const char* a1 = cA + (size_t)(t + 1) * kstep;
            const char* a2 = last ? nA : cA + (size_t)(t + 2) * kstep; const char* b2 = last ? nB : cB + (size_t)(t + 2) * kstep;
            const char* a3 = a2 + kstep; const char* b3 = b2 + kstep;
            if (last && has_next) S.a_ready(nxt);
            if constexpr (SP2) {
            PG8_LDB(B0, 0, 0); PG8_LDB(B1, 0, 1); PG8_SCHED; PG8_LDA(At, 0, 0); PG8_STAGE(PG8_SA(1, 1), a1 + hstep, voffA);
            PG8_WAIT_V(8); PG8_WAIT_L(0); PG8_BAR; PG8_MMA(0, 0, At, B0); PG8_MMA(0, 1, At, B1); PG8_BAR; PG8_SCHED;
            PG8_LDA(At, 0, 1); PG8_STAGE(PG8_SB(0, 0), b2, voffB); PG8_STAGE(PG8_SB(0, 1), b2 + hstep, voffB); PG8_STAGE(PG8_SA(0, 0), a2, voffA);
            PG8_WAIT_V(8); PG8_WAIT_L(0); PG8_BAR; PG8_MMA(1, 0, At, B0); PG8_MMA(1, 1, At, B1); PG8_BAR; PG8_SCHED;
            PG8_LDB(B0, 1, 0); PG8_LDB(B1, 1, 1); PG8_SCHED; PG8_LDA(At, 1, 0); PG8_STAGE(PG8_SA(0, 1), a2 + hstep, voffA);
            PG8_WAIT_V(8); PG8_WAIT_L(0); PG8_BAR; PG8_MMA(0, 0, At, B0); PG8_MMA(0, 1, At, B1); PG8_BAR; PG8_SCHED;
            PG8_LDA(At, 1, 1); PG8_STAGE(PG8_SB(1, 0), b3, voffB); PG8_STAGE(PG8_SB(1, 1), b3 + hstep, voffB); PG8_STAGE(PG8_SA(1, 0), a3, voffA);
            PG8_WAIT_V(8); PG8_WAIT_L(0); PG8_BAR; PG8_MMA(1, 0, At, B0); PG8_MMA(1, 1, At, B1); PG8_BAR; PG8_SCHED;
            } else {
            PG8_LDB(B0, 0, 0); PG8_SCHED; PG8_LDA(At, 0, 0); PG8_STAGE(PG8_SA(1, 1), a1 + hstep, voffA);
            PG8_WAIT_L(8); PG8_BAR; PG8_WAIT_L(0); PG8_MMA(0, 0, At, B0); PG8_BAR; PG8_SCHED;
            PG8_LDB(B1, 0, 1); PG8_STAGE(PG8_SB(0, 0), b2, voffB);
            PG8_BAR; PG8_WAIT_L(0); PG8_MMA(0, 1, At, B1); PG8_BAR;
            PG8_LDA(At, 0, 1); PG8_STAGE(PG8_SA(0, 0), a2, voffA);
            PG8_BAR; PG8_WAIT_L(0); PG8_MMA(1, 0, At, B0); PG8_BAR; PG8_SCHED;
            PG8_STAGE(PG8_SB(0, 1), b2 + hstep, voffB);
            PG8_WAIT_V(6); PG8_BAR; PG8_MMA(1, 1, At, B1); PG8_BAR;
            PG8_LDB(B0, 1, 0); PG8_SCHED; PG8_LDA(At, 1, 0); PG8_STAGE(PG8_SA(0, 1), a2 + hstep, voffA);
            PG8_WAIT_L(8); PG8_BAR; PG8_WAIT_L(0); PG8_MMA(0, 0, At, B0); PG8_BAR; PG8_SCHED;
            PG8_LDB(B1, 1, 1); PG8_STAGE(PG8_SB(1, 0), b3, voffB);
            PG8_BAR; PG8_WAIT_L(0); PG8_MMA(0, 1, At, B1); PG8_BAR;
            PG8_LDA(At, 1, 1); PG8_STAGE(PG8_SA(1, 0), a3, voffA);
            PG8_BAR; PG8_WAIT_L(0); PG8_MMA(1, 0, At, B0); PG8_BAR; PG8_SCHED;
            PG8_STAGE(PG8_SB(1, 1), b3 + hstep, voffB);
            PG8_WAIT_V(6); PG8_BAR; PG8_MMA(1, 1, At, B1); PG8_BAR;
            }
        }
        if constexpr (ALIGN_EPI) { if (wr == 0) PG8_BAR; }
        if constexpr (!Epi::AFTER_DRAIN) { E(acc, cur, wr, wc, fr, fq); S.done(cur); }
        if (!has_next) break;
#pragma unroll
        for (int a = 0; a < 2; ++a)
#pragma unroll
            for (int b = 0; b < 2; ++b)
#pragma unroll
                for (int m = 0; m < 4; ++m)
#pragma unroll
                    for (int n = 0; n < 2; ++n) acc[a][b][m][n] = (f32x4){0.f, 0.f, 0.f, 0.f};
        cur = nxt; cA = nA; cB = nB; ++ui;
        if constexpr (ALIGN_EPI) { if (wr == 1) PG8_BAR; }
    }
    PG8_WAIT_V(0);
    if constexpr (!ALIGN_EPI) { if (wr == 0) PG8_BAR; }
    PG8_BAR;
    if constexpr (Epi::AFTER_DRAIN) { E.fused(acc, cur, wr, wc, fr, fq, lds, wid, lane); S.done(cur); }
#undef PG8_SA
#undef PG8_SB
#undef PG8_STAGE
#undef PG8_LDA
#undef PG8_LDB
#undef PG8_MMA
#undef PG8_WAIT_V
#undef PG8_WAIT_L
#undef PG8_BAR
#undef PG8_SCHED
}
}
namespace attn_body {
using bf16=__hip_bfloat16;
using bf16x8=__attribute__((ext_vector_type(8)))short;
using s16x4=__attribute__((ext_vector_type(4)))short;
using f32x16=__attribute__((ext_vector_type(16)))float;
using u32x4=__attribute__((ext_vector_type(4)))unsigned;
constexpr int D=64,QP=512,KP=128;
constexpr int NW=8,QBLK=32,QB=QBLK*NW,KVBLK=64;
constexpr int ATTN_UNIT_ROWS=QB;
__device__ __forceinline__ int crow(int r,int hi){return (r&3)+8*(r>>2)+4*hi;}
#define SBAR() __builtin_amdgcn_sched_barrier(0)
constexpr int NSLOT=3, SLOTB=8192;
constexpr int LDS_K=0, LDS_V=NSLOT*SLOTB, LDS_WS=2*NSLOT*SLOTB, LDS_OST=LDS_WS+NW*64*4, LDS_BYTES=LDS_OST+NW*4096;
constexpr float C2=0.125f*1.4426950408889634f;
__device__ __forceinline__ void glds16(const void*gsrc,unsigned lds_dst){unsigned keep;
  asm volatile("s_mov_b32 %0, m0\n\ts_mov_b32 m0, %2\n\ts_nop 0\n\tglobal_load_lds_dwordx4 %1, off\n\ts_mov_b32 m0, %0":"=&s"(keep):"v"(gsrc),"s"(lds_dst):"memory");}
__device__ __forceinline__ float max3f(float a,float b,float c){float r;asm("v_max3_f32 %0, %1, %2, %3":"=v"(r):"v"(a),"v"(b),"v"(c));return r;}
__device__ __forceinline__ float max2f(float a,float b){float r;asm("v_max_f32_e32 %0, %1, %2":"=v"(r):"v"(a),"v"(b));return r;}
__device__ __forceinline__ float fadd_s(float a,float b){float r;asm("v_add_f32_e32 %0, %1, %2":"=v"(r):"v"(a),"v"(b));return r;}
__device__ __forceinline__ float fsub_s(float a,float b){float r;asm("v_sub_f32_e32 %0, %1, %2":"=v"(r):"v"(a),"v"(b));return r;}
typedef float f32x2_t __attribute__((ext_vector_type(2))); typedef __bf16 bf16x2_t __attribute__((ext_vector_type(2)));
__device__ __forceinline__ unsigned cvtpk_s(float lo,float hi){f32x2_t v={lo,hi};bf16x2_t b=__builtin_convertvector(v,bf16x2_t);return __builtin_bit_cast(unsigned,b);}
#define WAIT_BAR(N) asm volatile("s_waitcnt vmcnt(" #N ") lgkmcnt(0)\n\ts_barrier":::"memory")

__device__ __forceinline__ void qkt(f32x16&p0,f32x16&p1,const char*Kslot,const bf16x8*qr,const f32x16&negm,int r32,int hi){
  const char*kb=Kslot+hi*1024+r32*16;
  #pragma unroll
  for(int d0=0;d0<4;++d0){
    const bf16x8 b0=*reinterpret_cast<const bf16x8*>(kb+d0*2048);
    const bf16x8 b1=*reinterpret_cast<const bf16x8*>(kb+d0*2048+512);
    if(d0==0){p0=__builtin_amdgcn_mfma_f32_32x32x16_bf16(b0,qr[0],negm,0,0,0);p1=__builtin_amdgcn_mfma_f32_32x32x16_bf16(b1,qr[0],negm,0,0,0);}
    else{p0=__builtin_amdgcn_mfma_f32_32x32x16_bf16(b0,qr[d0],p0,0,0,0);p1=__builtin_amdgcn_mfma_f32_32x32x16_bf16(b1,qr[d0],p1,0,0,0);}}
}
typedef __attribute__((address_space(3))) const char* lds_cptr;
typedef short v4i16_t __attribute__((ext_vector_type(4)));
__device__ __forceinline__ void kload8(bf16x8*kf,lds_cptr kp){
  kf[0]=*(const __attribute__((address_space(3))) bf16x8*)(kp);      kf[1]=*(const __attribute__((address_space(3))) bf16x8*)(kp+512);
  kf[2]=*(const __attribute__((address_space(3))) bf16x8*)(kp+2048); kf[3]=*(const __attribute__((address_space(3))) bf16x8*)(kp+2560);
  kf[4]=*(const __attribute__((address_space(3))) bf16x8*)(kp+4096); kf[5]=*(const __attribute__((address_space(3))) bf16x8*)(kp+4608);
  kf[6]=*(const __attribute__((address_space(3))) bf16x8*)(kp+6144); kf[7]=*(const __attribute__((address_space(3))) bf16x8*)(kp+6656);
}
__device__ __forceinline__ void kload2(bf16x8*kf,lds_cptr kp,int j){ kf[2*j]=*(const __attribute__((address_space(3))) bf16x8*)(kp+j*2048); kf[2*j+1]=*(const __attribute__((address_space(3))) bf16x8*)(kp+j*2048+512); }
__device__ __forceinline__ s16x4 vtr(lds_cptr p){ return __builtin_bit_cast(s16x4,__builtin_amdgcn_ds_read_tr16_b64_v4i16((__attribute__((address_space(3))) v4i16_t*)p)); }
__device__ __forceinline__ float rowmax(const f32x16&p0,const f32x16&p1){
  float a=max3f(p0[0],p0[1],p1[0]),b=max3f(p0[2],p0[3],p1[1]);a=max3f(a,p1[2],p1[3]);
  #pragma unroll
  for(int r=4;r<16;r+=4){a=max3f(a,p0[r],p0[r+1]);b=max3f(b,p0[r+2],p0[r+3]);a=max3f(a,p1[r],p1[r+1]);b=max3f(b,p1[r+2],p1[r+3]);}
  const float m=max2f(a,b);
  auto rr=__builtin_amdgcn_permlane32_swap(__float_as_uint(m),__float_as_uint(m),false,false);
  return max2f(__uint_as_float(rr[0]),__uint_as_float(rr[1]));
}
__device__ __forceinline__ void pv(f32x16*o,int vb,bf16x8 pa0,bf16x8 pa1,bf16x8 pa2,bf16x8 pa3){
  #pragma unroll
  for(int d0=0;d0<2;++d0){s16x4 lo[4],hi[4];
    #pragma unroll
    for(int ks=0;ks<4;++ks){
      asm volatile("ds_read_b64_tr_b16 %0,%1 offset:%c2":"=&v"(lo[ks]):"v"(vb),"i"(d0*4096+ks*1024):"memory");
      asm volatile("ds_read_b64_tr_b16 %0,%1 offset:%c2":"=&v"(hi[ks]):"v"(vb),"i"(d0*4096+ks*1024+512):"memory");}
    asm volatile("s_waitcnt lgkmcnt(0)":::"memory");SBAR();
    #define PK(k) (bf16x8){lo[k][0],lo[k][1],lo[k][2],lo[k][3],hi[k][0],hi[k][1],hi[k][2],hi[k][3]}
    o[d0]=__builtin_amdgcn_mfma_f32_32x32x16_bf16(pa0,PK(0),o[d0],0,0,0);
    o[d0]=__builtin_amdgcn_mfma_f32_32x32x16_bf16(pa1,PK(1),o[d0],0,0,0);
    o[d0]=__builtin_amdgcn_mfma_f32_32x32x16_bf16(pa2,PK(2),o[d0],0,0,0);
    o[d0]=__builtin_amdgcn_mfma_f32_32x32x16_bf16(pa3,PK(3),o[d0],0,0,0);
    #undef PK
  }
}

#ifndef ATTN_STORE16
#define ATTN_STORE16(p,v) (*(u32x4*)(p)=(v))
#endif
typedef __attribute__((address_space(3))) const float* lds_cfptr;
__device__ __forceinline__ void biasmask(f32x16&p0,f32x16&p1,lds_cfptr tb){
  #pragma unroll
  for(int r=0;r<16;++r){p0[r]+=tb[(r&3)+8*(r>>2)];p1[r]+=tb[(r&3)+8*(r>>2)+32];}
}
template<int MODE,int THRL> __device__ __forceinline__ void attn_unit(long qrow0,long krow0,int NT,int relb,const bf16*Qh,const bf16*__restrict__ Kh,const bf16*__restrict__ Vh,bf16*Oh,lds_cfptr tbl,float sinkl2,char*shm,float sinkl2b=0.f,float rref=0.f){
  const int tid=threadIdx.x,lane=tid&63,r32=lane&31,hi=lane>>5; const int wid=__builtin_amdgcn_readfirstlane(tid>>6);
  const int hw_=(MODE==2)?(wid>>2):0, rw_=(MODE==2)?(wid&3):wid;
  const bf16*Qw=Qh+hw_*64+(qrow0+rw_*QBLK)*QP;
  const bf16*Kt=Kh+krow0*KP,*Vt=Vh+krow0*KP;
  const unsigned lds0=(unsigned)(uintptr_t)shm;
  float*wsf=(float*)(shm+LDS_WS)+wid*64;
  const bf16*ksrc=Kt+(long)lane*KP+wid*8;
  const bf16*vsrc=Vt+(long)(16*(wid&3)+(lane>>2))*KP+(wid>>2)*32+(lane&3)*8;
  const unsigned kdst=lds0+LDS_K+wid*1024, vdst=lds0+LDS_V+wid*1024;
  #define DMA_K(t,slot) glds16(ksrc+(long)(t)*KVBLK*KP,(unsigned)__builtin_amdgcn_readfirstlane(kdst+(slot)))
  #define DMA_V(t,slot) glds16(vsrc+(long)(t)*KVBLK*KP,(unsigned)__builtin_amdgcn_readfirstlane(vdst+(slot)))
  const int vb0=(int)(lds0+LDS_V)+((lane>>4)&1)*32+(lane&3)*8+(4*hi+((lane&15)>>2))*64;
  const char*Kbase=shm+LDS_K; bf16x8 kf[8];
  const lds_cptr shm3=(lds_cptr)shm; const lds_cptr kp0=shm3+LDS_K+hi*1024+r32*16; const lds_cptr vp0=shm3+LDS_V+((lane>>4)&1)*32+(lane&3)*8+(4*hi+((lane&15)>>2))*64;
  DMA_K(0,0);DMA_V(0,0);DMA_K(1,SLOTB);
  bf16x8 qr[4];
  #pragma unroll
  for(int d0=0;d0<4;++d0)qr[d0]=*reinterpret_cast<const bf16x8*>(&Qw[(long)r32*QP+d0*16+hi*8]);
  float mhat=0.f,l_reg=0.f;f32x16 o[2];o[0]=f32x16{};o[1]=f32x16{};f32x16 negm=f32x16{};asm volatile("":"+v"(negm));
  const lds_cfptr tb0=tbl+hw_*768+(relb-(rw_*QBLK+r32)+383+4*hi);
  #define CMASK(P0,P1,t) do{ if(MODE==1||MODE==2) biasmask(P0,P1,tb0+(t)*64); }while(0)
  bool resc=false;
  #define START(P0,P1) do{ const float rm=(MODE==3)?rref:rowmax(P0,P1); resc=false;     \
    { const float dl=(MODE==1||MODE==2)?__builtin_fmaxf(rm,-64.f):rm; mhat=fadd_s(mhat,dl); \
      _Pragma("unroll") for(int r=0;r<16;++r){P0[r]=fsub_s(P0[r],dl);P1[r]=fsub_s(P1[r],dl);} \
      _Pragma("unroll") for(int r=0;r<16;++r)negm[r]=-mhat; asm volatile("":"+v"(negm)); } \
    _Pragma("unroll") for(int r=0;r<16;++r)P0[r]=__builtin_amdgcn_exp2f(P0[r]); }while(0)
  #define RESC() do{ if(resc){ asm volatile("s_waitcnt lgkmcnt(0)":::"memory"); \
      _Pragma("unroll") for(int d_=0;d_<2;++d_) _Pragma("unroll") for(int r=0;r<16;++r)o[d_][r]*=wsf[crow(r,hi)]; } }while(0)
  f32x16 pA0,pA1,pB0,pB1;
  int sl_prev=0,sl_cur=0,sl_next=SLOTB;
  #define ROT() do{sl_prev=sl_cur;sl_cur=sl_next;sl_next=(sl_next==(NSLOT-1)*SLOTB)?0:sl_next+SLOTB;}while(0)
  DMA_K(2,2*SLOTB);
  WAIT_BAR(3);
  qkt(pA0,pA1,Kbase,qr,negm,r32,hi);asm volatile("s_nop 15\n\ts_nop 7":"+v"(pA0),"+v"(pA1));CMASK(pA0,pA1,0);
  START(pA0,pA1);
  _Pragma("unroll") for(int r=0;r<16;++r)pA1[r]=__builtin_amdgcn_exp2f(pA1[r]);
  WAIT_BAR(0);
  DMA_K(3,0);DMA_V(1,SLOTB);
  ROT();
  kload8(kf,kp0+sl_cur);
  WAIT_BAR(2);
  s16x4 vlo[8],vhi[8]; u32x4 pw0,pw1,pw2,pw3;
  #define PKW(P,B) cvtpk_s(P[B],P[B+1])
  #define PAF(k) __builtin_bit_cast(bf16x8,pw##k)
  #define VFR(i) (bf16x8){vlo[i][0],vlo[i][1],vlo[i][2],vlo[i][3],vhi[i][0],vhi[i][1],vhi[i][2],vhi[i][3]}
  #define PIN(x) asm volatile("":"+v"(x))
  #define MX3(a,b,c) __builtin_fmaxf(__builtin_fmaxf((a),(b)),(c))
  #define GAPA(MF,A0,A1,A2,A3,W0,W1,PW) do{ MF; sacc+=A0; sacc+=A1; sacc+=A2; sacc+=A3; PIN(sacc); W0; W1; PIN(PW); SBAR(); }while(0)
  #define EX(v) __builtin_amdgcn_exp2f(v)
  #define GAPB(MF,X,B) do{ MF; X[B]=EX(X[B]); X[B+1]=EX(X[B+1]); X[B+2]=EX(X[B+2]); X[B+3]=EX(X[B+3]); PIN(X); SBAR(); }while(0)
  #define VRD(i) do{ vlo[i]=vtr(vp_+(((i)>>2)*4096+((i)&3)*1024)); vhi[i]=vtr(vp_+(((i)>>2)*4096+((i)&3)*1024+512)); }while(0)
  #define KRD(G,j) do{ if(G){ kload2(kf,kp0+sl_next,j); SBAR(); } }while(0)
  #define STEP(C0,C1,P0,P1,t,GK,GV,GL) do{ SBAR(); \
    const lds_cptr vp_=vp0+sl_prev; \
    VRD(0); SBAR(); float sacc=(P0[0]+P0[1]); \
    GAPA(C0=__builtin_amdgcn_mfma_f32_32x32x16_bf16(kf[0],qr[0],negm,0,0,0), P0[2],P0[3],P0[4],P0[5],     pw0[0]=PKW(P0,0), pw0[1]=PKW(P0,2), pw0); \
    VRD(4); SBAR(); GAPA(C1=__builtin_amdgcn_mfma_f32_32x32x16_bf16(kf[1],qr[0],negm,0,0,0), P0[6],P0[7],P0[8],P0[9],     pw0[2]=PKW(P0,4), pw0[3]=PKW(P0,6), pw0); \
    VRD(1); SBAR(); GAPA(C0=__builtin_amdgcn_mfma_f32_32x32x16_bf16(kf[2],qr[1],C0,0,0,0),   P0[10],P0[11],P0[12],P0[13], pw1[0]=PKW(P0,8), pw1[1]=PKW(P0,10), pw1); \
    VRD(5); SBAR(); GAPA(C1=__builtin_amdgcn_mfma_f32_32x32x16_bf16(kf[3],qr[1],C1,0,0,0),   P0[14],P0[15],P1[0],P1[1],   pw1[2]=PKW(P0,12),pw1[3]=PKW(P0,14), pw1); \
    VRD(2); SBAR(); GAPA(C0=__builtin_amdgcn_mfma_f32_32x32x16_bf16(kf[4],qr[2],C0,0,0,0),   P1[2],P1[3],P1[4],P1[5],     pw2[0]=PKW(P1,0), pw2[1]=PKW(P1,2), pw2); \
    VRD(6); SBAR(); GAPA(C1=__builtin_amdgcn_mfma_f32_32x32x16_bf16(kf[5],qr[2],C1,0,0,0),   P1[6],P1[7],P1[8],P1[9],     pw2[2]=PKW(P1,4), pw2[3]=PKW(P1,6), pw2); \
    VRD(3); SBAR(); GAPA(C0=__builtin_amdgcn_mfma_f32_32x32x16_bf16(kf[6],qr[3],C0,0,0,0),   P1[10],P1[11],P1[12],P1[13], pw3[0]=PKW(P1,8), pw3[1]=PKW(P1,10), pw3); \
    VRD(7); SBAR(); GAPA(C1=__builtin_amdgcn_mfma_f32_32x32x16_bf16(kf[7],qr[3],C1,0,0,0),   P1[14],P1[15],0.f,0.f,       pw3[2]=PKW(P1,12),pw3[3]=PKW(P1,14), pw3); \
    l_reg+=sacc; \
    if(GK){DMA_K((t)+3,sl_cur);} if(GV){DMA_V((t)+1,sl_next);} \
    CMASK(C0,C1,t); \
    if(MODE!=3){ float a=MX3(C0[0],C0[1],C1[0]),b=MX3(C0[2],C0[3],C1[1]); a=MX3(a,C1[2],C1[3]); \
      _Pragma("unroll") for(int r=4;r<16;r+=4){a=MX3(a,C0[r],C0[r+1]);b=MX3(b,C0[r+2],C0[r+3]);a=MX3(a,C1[r],C1[r+1]);b=MX3(b,C1[r+2],C1[r+3]);} \
      float rm=__builtin_fmaxf(a,b); { auto rr=__builtin_amdgcn_permlane32_swap(__float_as_uint(rm),__float_as_uint(rm),false,false); rm=__builtin_fmaxf(__uint_as_float(rr[0]),__uint_as_float(rr[1])); } \
      resc=false; \
      if(__builtin_expect(__any(rm>(float)THRL),0)){ const float dl=__builtin_fmaxf(rm,0.f); mhat+=dl; \
        _Pragma("unroll") for(int r=0;r<16;++r){C0[r]-=dl;C1[r]-=dl;} \
        _Pragma("unroll") for(int r=0;r<16;++r)negm[r]=-mhat; asm volatile("":"+v"(negm)); \
        const float f=__builtin_amdgcn_exp2f(-dl); l_reg*=f; if(hi==0)wsf[r32]=f; resc=true; } } \
    SBAR(); \
    GAPB(o[0]=__builtin_amdgcn_mfma_f32_32x32x16_bf16(PAF(0),VFR(0),o[0],0,0,0), C0,0); \
    GAPB(o[1]=__builtin_amdgcn_mfma_f32_32x32x16_bf16(PAF(0),VFR(4),o[1],0,0,0), C0,4); \
    KRD(GL,0); GAPB(o[0]=__builtin_amdgcn_mfma_f32_32x32x16_bf16(PAF(1),VFR(1),o[0],0,0,0), C0,8); \
    KRD(GL,1); GAPB(o[1]=__builtin_amdgcn_mfma_f32_32x32x16_bf16(PAF(1),VFR(5),o[1],0,0,0), C0,12); \
    KRD(GL,2); GAPB(o[0]=__builtin_amdgcn_mfma_f32_32x32x16_bf16(PAF(2),VFR(2),o[0],0,0,0), C1,0); \
    KRD(GL,3); GAPB(o[1]=__builtin_amdgcn_mfma_f32_32x32x16_bf16(PAF(2),VFR(6),o[1],0,0,0), C1,4); \
    GAPB(o[0]=__builtin_amdgcn_mfma_f32_32x32x16_bf16(PAF(3),VFR(3),o[0],0,0,0), C1,8); \
    GAPB(o[1]=__builtin_amdgcn_mfma_f32_32x32x16_bf16(PAF(3),VFR(7),o[1],0,0,0), C1,12); \
    }while(0)
  int t=1;
  for(;t+5<NT;t+=2){
    STEP(pB0,pB1,pA0,pA1,t,true,true,true);     WAIT_BAR(2); RESC(); ROT();
    STEP(pA0,pA1,pB0,pB1,t+1,true,true,true);   WAIT_BAR(2); RESC(); ROT();
  }
  #define ENDW(tt) do{ if((tt)+3<NT){WAIT_BAR(2);} else if((tt)+2<NT){WAIT_BAR(1);} else {WAIT_BAR(0);} }while(0)
  for(;t+1<NT;t+=2){
    STEP(pB0,pB1,pA0,pA1,t,(t+3<NT),(t+1<NT),(t+1<NT));       ENDW(t);   RESC(); ROT();
    STEP(pA0,pA1,pB0,pB1,t+1,(t+4<NT),(t+2<NT),(t+2<NT));     ENDW(t+1); RESC(); ROT();
  }
  STEP(pB0,pB1,pA0,pA1,NT-1,false,false,false); RESC();
  { float sacc=pB0[0]+pB0[1]; _Pragma("unroll") for(int r=2;r<16;++r)sacc+=pB0[r]; _Pragma("unroll") for(int r=0;r<16;++r)sacc+=pB1[r]; l_reg+=sacc;
    pw0=(u32x4){PKW(pB0,0),PKW(pB0,2),PKW(pB0,4),PKW(pB0,6)};pw1=(u32x4){PKW(pB0,8),PKW(pB0,10),PKW(pB0,12),PKW(pB0,14)};pw2=(u32x4){PKW(pB1,0),PKW(pB1,2),PKW(pB1,4),PKW(pB1,6)};pw3=(u32x4){PKW(pB1,8),PKW(pB1,10),PKW(pB1,12),PKW(pB1,14)};
    SBAR(); pv(o,vb0+sl_cur,PAF(0),PAF(1),PAF(2),PAF(3)); }
  #undef PKW
  #undef PAF
  #undef VFR
  #undef PIN
  #undef MX3
  #undef GAPA
  #undef GAPB
  #undef EX
  #undef VRD
  #undef KRD
  #undef STEP
  #undef ENDW
  {auto rr=__builtin_amdgcn_permlane32_swap(__float_as_uint(l_reg),__float_as_uint(l_reg),false,false);l_reg=__uint_as_float(rr[0])+__uint_as_float(rr[1]);}
  if(MODE==1||MODE==2)l_reg+=__builtin_amdgcn_exp2f(((MODE==2&&hw_)?sinkl2b:sinkl2)-mhat);
  if(hi==0)wsf[32+r32]=l_reg;asm volatile("s_waitcnt lgkmcnt(0)":::"memory");
  float rli[16];
  #pragma unroll
  for(int r=0;r<16;++r)rli[r]=__builtin_amdgcn_rcpf(wsf[32+crow(r,hi)]);
  bf16*Ow=Oh+hw_*64+(qrow0+rw_*QBLK)*QP;
  { bf16*stg=(bf16*)(shm+LDS_OST)+wid*2048;
    #pragma unroll
    for(int r=0;r<16;++r){const int orow=crow(r,hi);
      #pragma unroll
      for(int d0=0;d0<2;++d0)stg[orow*64+d0*32+r32]=__float2bfloat16(o[d0][r]*rli[r]);}
    asm volatile("s_waitcnt lgkmcnt(0)":::"memory");
    #pragma unroll
    for(int i=0;i<4;++i){const int row=i*8+(lane>>3),ch=lane&7; const u32x4 v=*(const u32x4*)(stg+row*64+ch*8); ATTN_STORE16(Ow+(long)row*QP+ch*8,v);} }
  asm volatile("s_waitcnt lgkmcnt(0)\n\ts_barrier":::"memory");
  #undef DMA_K
  #undef DMA_V
  #undef CMASK
  #undef START
  #undef RESC
  #undef ROT
}
constexpr int ATTN_LDS_BYTES=LDS_BYTES;
#undef SBAR
#undef WAIT_BAR
}

constexpr int NWAVES = 8;
constexpr int N_PHASES = 12;
#ifndef STAGGER
#define STAGGER 8
#endif
#ifndef GEMM_ALIGN
#define GEMM_ALIGN true
#endif
#ifndef GEMM_SP2
#define GEMM_SP2 true
#endif
constexpr int RING_BYTES = 131072, LDS_BYTES = 147456;
constexpr int ATT_TBL_OFF = 86016;
static_assert(attn_body::ATTN_LDS_BYTES <= ATT_TBL_OFF && ATT_TBL_OFF + 8 * 768 * 4 <= RING_BYTES, "lds map");

#define GAS __attribute__((address_space(1)))
#define LAS __attribute__((address_space(3)))
typedef unsigned short bf16;
typedef unsigned v4u __attribute__((ext_vector_type(4)));
typedef unsigned v2u __attribute__((ext_vector_type(2)));
typedef float f32x4 __attribute__((ext_vector_type(4)));
#define LDS_WAIT() asm volatile("s_waitcnt lgkmcnt(0)" ::: "memory")
__device__ __forceinline__ unsigned f2bf(float f) { unsigned u = __builtin_bit_cast(unsigned, f); return (u + 0x7fffu + ((u >> 16) & 1u)) >> 16; }
__device__ __forceinline__ unsigned pk2(float lo, float hi) { return f2bf(lo) | (f2bf(hi) << 16); }
__device__ __forceinline__ float wave_sum(float v) {
#pragma unroll
    for (int o = 1; o < 64; o <<= 1) v += __shfl_xor(v, o);
    return v;
}
__device__ __forceinline__ int rowmap(int mode, int j) {
    if (mode == 1) { const int b = j >= DFF ? 1 : 0, jj = j - b * DFF; return 256 * (jj >> 7) + 128 * b + (jj & 127); }
    if (mode == 2 && j < 1536) { const int L = j & 255; return (j & ~255) + 128 * ((L >> 4) & 1) + 32 * (L >> 6) + 16 * ((L >> 5) & 1) + (L & 15); }
    return j;
}
__device__ __forceinline__ void p0_transpose_item(const float* W, int K, int N, bf16* WT, int mode, LAS float* scr, int item, int lane, const float* gk = nullptr) {
    const int nblk = N / 32, kb = item / nblk, nb = item % nblk, k0 = 64 * kb, n0 = 32 * nb;
    float wv[32];
#pragma unroll
    for (int i = 0; i < 32; ++i) { const int kk = 2 * i + (lane >> 5); wv[i] = W[(size_t)(k0 + kk) * N + n0 + (lane & 31)]; }
#pragma unroll
    for (int i = 0; i < 32; ++i) { const int kk = 2 * i + (lane >> 5); scr[kk * 33 + (lane & 31)] = wv[i] * (gk ? gk[k0 + kk] : 1.0f); }
    LDS_WAIT(); asm volatile("" ::: "memory");
    const int c = lane & 7;
#pragma unroll
    for (int j = 0; j < 4; ++j) { const int n = (lane >> 3) + 8 * j; const LAS float* s = scr + (8 * c) * 33 + n;
        v4u o; o.x = pk2(s[0 * 33], s[1 * 33]); o.y = pk2(s[2 * 33], s[3 * 33]); o.z = pk2(s[4 * 33], s[5 * 33]); o.w = pk2(s[6 * 33], s[7 * 33]);
        *(GAS v4u*)(WT + (size_t)rowmap(mode, n0 + n) * K + k0 + 8 * c) = o; }
    LDS_WAIT(); asm volatile("" ::: "memory");
}
__device__ __forceinline__ void rms_row_to_bf16(const float* xrow, const float* g, bf16* orow, int lane) {
    const GAS f32x4* xr = (const GAS f32x4*)xrow + lane; const GAS f32x4* gr = (const GAS f32x4*)g + lane;
    f32x4 v[4]; float s = 0.f;
#pragma unroll
    for (int j = 0; j < 4; ++j) { v[j] = xr[64 * j]; s += (v[j].x * v[j].x + v[j].y * v[j].y) + (v[j].z * v[j].z + v[j].w * v[j].w); }
    const float rinv = 1.f / sqrtf(wave_sum(s) * (1.f / DM) + EPS);
    GAS v2u* o8 = (GAS v2u*)orow + lane;
#pragma unroll
    for (int j = 0; j < 4; ++j) { const f32x4 gg = gr[64 * j]; v2u o; o.x = pk2(v[j].x * rinv * gg.x, v[j].y * rinv * gg.y); o.y = pk2(v[j].z * rinv * gg.z, v[j].w * rinv * gg.w); o8[64 * j] = o; }
}
__device__ __forceinline__ void rms_row2_to_bf16(const float* x0, const float* x1, const float* g, bf16* o0, bf16* o1, int lane) {
    const GAS f32x4* xr0 = (const GAS f32x4*)x0 + lane; const GAS f32x4* xr1 = (const GAS f32x4*)x1 + lane; const GAS f32x4* gr = (const GAS f32x4*)g + lane;
    f32x4 v[4], w[4]; float s = 0.f, t = 0.f;
#pragma unroll
    for (int j = 0; j < 4; ++j) { v[j] = xr0[64 * j]; w[j] = xr1[64 * j]; }
#pragma unroll
    for (int j = 0; j < 4; ++j) { s += (v[j].x * v[j].x + v[j].y * v[j].y) + (v[j].z * v[j].z + v[j].w * v[j].w); t += (w[j].x * w[j].x + w[j].y * w[j].y) + (w[j].z * w[j].z + w[j].w * w[j].w); }
    const float ri = 1.f / sqrtf(wave_sum(s) * (1.f / DM) + EPS), rj = 1.f / sqrtf(wave_sum(t) * (1.f / DM) + EPS);
    GAS v2u* p0 = (GAS v2u*)o0 + lane; GAS v2u* p1 = (GAS v2u*)o1 + lane;
#pragma unroll
    for (int j = 0; j < 4; ++j) { const f32x4 gg = gr[64 * j]; v2u o; o.x = pk2(v[j].x * ri * gg.x, v[j].y * ri * gg.y); o.y = pk2(v[j].z * ri * gg.z, v[j].w * ri * gg.w); p0[64 * j] = o;
        o.x = pk2(w[j].x * rj * gg.x, w[j].y * rj * gg.y); o.y = pk2(w[j].z * rj * gg.z, w[j].w * rj * gg.w); p1[64 * j] = o; }
}
__device__ __forceinline__ void rms_row2_inplace(float* x0, float* x1, const float* g, int lane) {
    GAS f32x4* xr0 = (GAS f32x4*)x0 + lane; GAS f32x4* xr1 = (GAS f32x4*)x1 + lane; const GAS f32x4* gr = (const GAS f32x4*)g + lane;
    f32x4 v[4], w[4]; float s = 0.f, t = 0.f;
#pragma unroll
    for (int j = 0; j < 4; ++j) { v[j] = xr0[64 * j]; w[j] = xr1[64 * j]; }
#pragma unroll
    for (int j = 0; j < 4; ++j) { s += (v[j].x * v[j].x + v[j].y * v[j].y) + (v[j].z * v[j].z + v[j].w * v[j].w); t += (w[j].x * w[j].x + w[j].y * w[j].y) + (w[j].z * w[j].z + w[j].w * w[j].w); }
    const float ri = 1.f / sqrtf(wave_sum(s) * (1.f / DM) + EPS), rj = 1.f / sqrtf(wave_sum(t) * (1.f / DM) + EPS);
#pragma unroll
    for (int j = 0; j < 4; ++j) { const f32x4 gg = gr[64 * j]; xr0[64 * j] = v[j] * ri * gg; xr1[64 * j] = w[j] * rj * gg; }
}
__device__ __forceinline__ void rms_row_inplace(float* xrow, const float* g, int lane) {
    GAS f32x4* xr = (GAS f32x4*)xrow + lane; const GAS f32x4* gr = (const GAS f32x4*)g + lane;
    f32x4 v[4]; float s = 0.f;
#pragma unroll
    for (int j = 0; j < 4; ++j) { v[j] = xr[64 * j]; s += (v[j].x * v[j].x + v[j].y * v[j].y) + (v[j].z * v[j].z + v[j].w * v[j].w); }
    const float rinv = 1.f / sqrtf(wave_sum(s) * (1.f / DM) + EPS);
#pragma unroll
    for (int j = 0; j < 4; ++j) xr[64 * j] = v[j] * rinv * gr[64 * j];
}
__device__ __forceinline__ void rope_entry(int pos, int j, float& c, float& s) {
    const float inv = __builtin_amdgcn_exp2f(-0.8304820237218405f * (float)j), ang = (float)pos * inv;
    const float k = rintf(ang * 0.6366197723675814f);
    float r = fmaf(-k, 1.57079637050628662109375f, ang); r = fmaf(-k, -4.37113900018624283e-8f, r);
    const float r2 = r * r;
    const float sp = r + r * r2 * (-1.6666666666666666e-1f + r2 * (8.333333333333333e-3f + r2 * (-1.984126984126984e-4f + r2 * 2.7557319223985893e-6f)));
    const float cp = 1.0f + r2 * (-0.5f + r2 * (4.1666666666666664e-2f + r2 * (-1.3888888888888889e-3f + r2 * (2.48015873015873e-5f + r2 * -2.755731922398589e-7f))));
    const int q = ((int)k) & 3;
    s = (q == 0) ? sp : (q == 1) ? cp : (q == 2) ? -sp : -cp;
    c = (q == 0) ? cp : (q == 1) ? -sp : (q == 2) ? -cp : sp;
}
__device__ __forceinline__ int t5_bucket(int rel) {
    const int n = rel < 0 ? -rel : rel; int v;
    if (n < 8) v = n; else { const int lg = 31 - __builtin_clz((unsigned)(n * n) >> 6); v = 8 + lg; v = v > 15 ? 15 : v; }
    return (rel > 0 ? 16 : 0) + v;
}


#define XB_TMO      128
#define XB_XCNT(j)  (256  + 64 * (j))
#define XB_XSUB(j)  (1280 + 64 * (j))
#define XB_XGEN(j)  (2304 + 64 * (j))
#define XB_TOP      3328
#define XB_TOPGEN   3392
#define XCD_BAR_WORDS 3456
#define XB_SPIN_CAP (1u << 18)

__device__ __forceinline__ unsigned xb_ld(unsigned* p)              { return __hip_atomic_load(p, __ATOMIC_RELAXED, __HIP_MEMORY_SCOPE_AGENT); }
__device__ __forceinline__ unsigned xb_add(unsigned* p, unsigned v) { return __hip_atomic_fetch_add(p, v, __ATOMIC_RELAXED, __HIP_MEMORY_SCOPE_AGENT); }
__device__ __forceinline__ unsigned xb_xcc_id() { return (unsigned)__builtin_amdgcn_s_getreg((3 << 11) | 20) & 0xFu; }
#define XB_SPIN(cond, bar) do { unsigned _sp = 0; while (cond) { __builtin_amdgcn_s_sleep(1); \
    if ((++_sp & 255u) == 0u) { if (xb_ld(&(bar)[XB_TMO])) break; if (_sp > XB_SPIN_CAP) { atomicAdd(&(bar)[XB_TMO], 1u); break; } } } } while (0)

struct XcdBarrier {
    unsigned* bar; unsigned x;
    volatile LAS unsigned* st;
};

__device__ __forceinline__ XcdBarrier xcd_barrier_post(unsigned* bar, volatile LAS unsigned* st) {
    XcdBarrier b; b.bar = bar; b.x = xb_xcc_id(); b.st = st;
    if (threadIdx.x == 0) (void)xb_add(&bar[XB_XCNT(b.x)], 1u);
    return b;
}
__device__ __forceinline__ void xcd_barrier_complete(unsigned* bar, unsigned x, unsigned& nloc, unsigned& nx) {
    const unsigned G = gridDim.x * gridDim.y * gridDim.z;
    unsigned sum, cnt, mine, sp = 0u;
    for (;;) {
        sum = 0u; cnt = 0u; mine = 0u;
#pragma unroll
        for (unsigned j = 0; j < 16; ++j) { const unsigned c = xb_ld(&bar[XB_XCNT(j)]); sum += c; cnt += (c > 0u) ? 1u : 0u; mine = (j == x) ? c : mine; }
        if (sum == G) break;
        __builtin_amdgcn_s_sleep(1);
        if ((++sp & 255u) == 0u) { if (xb_ld(&bar[XB_TMO])) break; if (sp > XB_SPIN_CAP) { atomicAdd(&bar[XB_TMO], 1u); break; } }
    }
    nloc = mine > 0u ? mine : 1u; nx = cnt > 0u ? cnt : 1u;
}

__device__ __forceinline__ void xcd_barrier(const XcdBarrier& b) {
    asm volatile("s_waitcnt vmcnt(0)" ::: "memory");
    __syncthreads();
    if (threadIdx.x == 0) {
        unsigned* bar = b.bar;
        __builtin_amdgcn_s_waitcnt(0);
        unsigned nloc = b.st[0], nx = b.st[1];
        if (nloc == 0u) { xcd_barrier_complete(bar, b.x, nloc, nx); b.st[0] = nloc; b.st[1] = nx; }
        const unsigned old = xb_add(&bar[XB_XSUB(b.x)], 1u);
        const unsigned gen = old / nloc;
        if (old + 1u == (gen + 1u) * nloc) {
            __builtin_amdgcn_fence(__ATOMIC_RELEASE, "agent");
            asm volatile("s_waitcnt vmcnt(0)" ::: "memory");
            const unsigned og = xb_add(&bar[XB_TOP], 1u);
            const unsigned tg = og / nx;
            if (og + 1u == (tg + 1u) * nx) xb_add(&bar[XB_TOPGEN], 1u);
            else XB_SPIN(xb_ld(&bar[XB_TOPGEN]) == tg, bar);
            __builtin_amdgcn_fence(__ATOMIC_ACQUIRE, "agent");
            xb_add(&bar[XB_XGEN(b.x)], 1u);
            asm volatile("s_waitcnt vmcnt(0)" ::: "memory");
        } else {
            XB_SPIN(xb_ld(&bar[XB_XGEN(b.x)]) == gen, bar);
            __builtin_amdgcn_fence(__ATOMIC_ACQUIRE, "agent");
            asm volatile("s_waitcnt vmcnt(0)" ::: "memory");
        }
    }
    __syncthreads();
}
struct Args { const float* in[18]; float* out; unsigned char* ws; int ph_lo, ph_hi; };
__global__ void __launch_bounds__(NWAVES * 64, 2) mega_fwd(Args args) {
    extern __shared__ __attribute__((aligned(16))) unsigned char lds[];
    LAS unsigned char* const ldsl = (LAS unsigned char*)lds;
    const int tid = threadIdx.x, lane = tid & 63, wave = __builtin_amdgcn_readfirstlane(tid >> 6);
    const int G = gridDim.x; const int bx = blockIdx.x; const int vcu = (G % 8 == 0) ? (bx % 8) * (G / 8) + bx / 8 : bx;
    cg::grid_group grid = cg::this_grid();
    volatile LAS unsigned* const MISC = (volatile LAS unsigned*)(ldsl + RING_BYTES + 320);
    if (tid < 32) MISC[tid] = 0u;
    __syncthreads();
    if (args.ph_hi < 0) grid.sync();
    XcdBarrier xbar = xcd_barrier_post((unsigned*)args.ws + 4096, MISC + 8);
    unsigned char* const ws = args.ws;
    const float* xp = args.in[0]; const float* xs = args.in[1];
    float* const out = args.out;
    bf16* const W1in = (bf16*)(ws + WS_W1IN); bf16* const W1out = (bf16*)(ws + WS_W1OUT); bf16* const Win = (bf16*)(ws + WS_WIN); bf16* const Wa = (bf16*)(ws + WS_WA);
    bf16* const Wb = (bf16*)(ws + WS_WB); bf16* const Wo = (bf16*)(ws + WS_WO); bf16* const W2in = (bf16*)(ws + WS_W2IN); bf16* const W2out = (bf16*)(ws + WS_W2OUT);
    float* const rope = (float*)(ws + WS_ROPE);
    bf16* const XN = (bf16*)(ws + WS_XN); bf16* const ACT = (bf16*)(ws + WS_ACT);
    bf16* const QA = (bf16*)(ws + WS_QA); bf16* const QB = (bf16*)(ws + WS_QB); bf16* const KA = (bf16*)(ws + WS_KA); bf16* const VA = (bf16*)(ws + WS_VA);
    bf16* const KB = (bf16*)(ws + WS_KB); bf16* const VB = (bf16*)(ws + WS_VB); bf16* const GA = (bf16*)(ws + WS_GA); bf16* const GB = (bf16*)(ws + WS_GB);
    float* const SSQ = (float*)(ws + WS_SSQ);
    bf16* const MG = (bf16*)(ws + WS_GA);
    const int lo = args.ph_lo, hi = args.ph_hi;
    const int gw = vcu * NWAVES + wave, NGW = G * NWAVES;
#define IN(k) (lo <= (k) && (k) < hi)
#define SEAM(k) do { xcd_barrier(xbar); } while (0)

    if (IN(0)) {
        LAS float* scr = (LAS float*)(ldsl + wave * 16384);
        constexpr int I_IN = (DM / 64) * (2 * DFF / 32), I_OUT = (DFF / 64) * (DM / 32), I_MIX = (DM / 64) * (NIN / 32), I_BR = (512 / 64) * (DM / 32), I_O = (DM / 64) * (DM / 32);
        constexpr int NITEMS = 2 * I_IN + 2 * I_OUT + I_MIX + 2 * I_BR + I_O;
        for (int it = gw; it < NITEMS; it += NGW) {
            int r = it;
            if (r < I_IN)  { p0_transpose_item(args.in[3], DM, 2 * DFF, W1in, 1, scr, r, lane); continue; } r -= I_IN;
            if (r < I_IN)  { p0_transpose_item(args.in[14], DM, 2 * DFF, W2in, 1, scr, r, lane, args.in[13]); continue; } r -= I_IN;
            if (r < I_OUT) { p0_transpose_item(args.in[4], DFF, DM, W1out, 0, scr, r, lane); continue; } r -= I_OUT;
            if (r < I_OUT) { p0_transpose_item(args.in[15], DFF, DM, W2out, 0, scr, r, lane); continue; } r -= I_OUT;
            if (r < I_MIX) { p0_transpose_item(args.in[6], DM, NIN, Win, 2, scr, r, lane, args.in[5]); continue; } r -= I_MIX;
            if (r < I_BR)  { p0_transpose_item(args.in[10], 512, DM, Wa, 0, scr, r, lane); continue; } r -= I_BR;
            if (r < I_BR)  { p0_transpose_item(args.in[11], 512, DM, Wb, 0, scr, r, lane); continue; } r -= I_BR;
            p0_transpose_item(args.in[12], DM, DM, Wo, 0, scr, r, lane);
        }
        { const int gt = vcu * (NWAVES * 64) + tid; if (gt < 128 * 16) { float c, s; rope_entry(gt >> 4, gt & 15, c, s); rope[(gt >> 4) * 32 + (gt & 15)] = c; rope[(gt >> 4) * 32 + 16 + (gt & 15)] = s; } }
        for (int m = gw; m < M / 2; m += NGW) { const int m1 = m + M / 2;
            rms_row2_to_bf16(xp + (size_t)m * DM, m1 < MP ? xp + (size_t)m1 * DM : xs + (size_t)(m1 - MP) * DM, args.in[2], XN + (size_t)m * DM, XN + (size_t)m1 * DM, lane); }
    }
    SEAM(0);
    if (IN(1)) {
        pg8::Gemm g{XN, W1in, M, 2 * DFF, DM}; pg8::StaticOrder S; S.init(M, 2 * DFF, G, bx);
        pg8::EpiSwiglu E{ws, false};
        pg8::gemm_phase<pg8::EpiSwiglu, pg8::StaticOrder, GEMM_ALIGN, GEMM_SP2>(ldsl, g, S, E);
    }
    SEAM(1);
    if (IN(2)) {
        pg8::Gemm g{ACT, W1out, M, DM, DFF}; pg8::StaticOrder S; S.init(M, DM, G, bx);
        pg8::EpiResid<true> E{xp, xs - (size_t)MP * DM, MP, out, 0.5f, ws};
        pg8::gemm_phase<pg8::EpiResid<true>, pg8::StaticOrder, false, GEMM_SP2>(ldsl, g, S, E);
    }
    SEAM(2);
    if (IN(4)) {
        pg8::Gemm g{XN, Win, M, NIN, DM}; pg8::StaticOrder S; S.init(M, NIN, G, bx);
        pg8::EpiMix E{ws, args.in[7], args.in[8]};
        pg8::gemm_phase<pg8::EpiMix, pg8::StaticOrder, GEMM_ALIGN, GEMM_SP2>(ldsl, g, S, E);
    }
    SEAM(4);
    if (IN(5)) {
        LAS float* tbl = (LAS float*)(ldsl + ATT_TBL_OFF);
        for (int i = tid; i < 8 * 768; i += NWAVES * 64) { const int h = i / 768, rel = (i % 768) - 383; const int ar = rel < 0 ? -rel : rel;
            tbl[i] = (ar <= 128) ? args.in[16][t5_bucket(rel) * 8 + h] * LOG2E : -1e30f; }
        __syncthreads();
        typedef attn_body::bf16 abf;
        float rref; { float gq = fabsf(args.in[7][lane]), gk = fabsf(args.in[8][lane]);
#pragma unroll
            for (int o = 1; o < 64; o <<= 1) { gq = fmaxf(gq, __shfl_xor(gq, o)); gk = fmaxf(gk, __shfl_xor(gk, o)); }
            rref = 1.02f * 8.0f * gq * gk * LOG2E; }
        const bool fixedref = rref < 60.0f;
        { const int per = (1024 + G - 1) / G;
          for (int i = 0; i < per; ++i) { const int u = vcu * per + i; if (u >= 1024) break; const int bh = u >> 5, qb = u & 31, b = bh >> 3, h = bh & 7;
            const long r0 = (long)b * TP;
            if (fixedref) attn_body::attn_unit<3, 8>(r0 + qb * 256, r0, TP / 64, 0, (const abf*)QA + h * 64, (const abf*)KA + (h >> 2) * 64, (const abf*)VA + (h >> 2) * 64, (abf*)QA + h * 64, tbl, 0.f, (char*)lds, 0.f, rref);
            else attn_body::attn_unit<0, 8>(r0 + qb * 256, r0, TP / 64, 0, (const abf*)QA + h * 64, (const abf*)KA + (h >> 2) * 64, (const abf*)VA + (h >> 2) * 64, (abf*)QA + h * 64, tbl, 0.f, (char*)lds); } }
        { const int per = (512 + G - 1) / G;
          for (int i = 0; i < per; ++i) { const int u = vcu * per + i; if (u >= 512) break; const int bh = u >> 4, qb = u & 15, b = bh >> 3, h = bh & 7;
            const long r0 = (long)MP + (long)b * TS;
            if (fixedref) attn_body::attn_unit<3, 8>(r0 + qb * 256, r0, TS / 64, 0, (const abf*)QA + h * 64, (const abf*)KA + (h >> 2) * 64, (const abf*)VA + (h >> 2) * 64, (abf*)QA + h * 64, tbl, 0.f, (char*)lds, 0.f, rref);
            else attn_body::attn_unit<0, 8>(r0 + qb * 256, r0, TS / 64, 0, (const abf*)QA + h * 64, (const abf*)KA + (h >> 2) * 64, (const abf*)VA + (h >> 2) * 64, (abf*)QA + h * 64, tbl, 0.f, (char*)lds); } }
        { const int per = (1536 + G - 1) / G;
          for (int i = 0; i < per; ++i) { const int u = vcu * per + i; if (u >= 1536) break; const int rb = u >> 2, h = (u & 3) * 2;
            long r0; int q0, T;
            if (rb < MP / 128) { r0 = (long)(rb / (TP / 128)) * TP; q0 = (rb % (TP / 128)) * 128; T = TP; } else { const int r2 = rb - MP / 128; r0 = (long)MP + (long)(r2 / (TS / 128)) * TS; q0 = (r2 % (TS / 128)) * 128; T = TS; }
            const int k0 = q0 >= 128 ? q0 - 128 : 0, k1 = q0 + 256 <= T ? q0 + 256 : T;
            attn_body::attn_unit<2, 8>(r0 + q0, r0 + k0, (k1 - k0) / 64, k0 - q0, (const abf*)QB + h * 64, (const abf*)KB + (h >> 2) * 64, (const abf*)VB + (h >> 2) * 64, (abf*)QB + h * 64, tbl + h * 768, args.in[9][h] * LOG2E, (char*)lds, args.in[9][h + 1] * LOG2E); } }
    }
    SEAM(5);
    if (IN(6)) {
        { pg8::Gemm g{QA, Wa, M, DM, 512}; pg8::StaticOrder S; S.init(M, DM, G, bx); pg8::EpiGate<false> E{ws};
          pg8::gemm_phase<pg8::EpiGate<false>, pg8::StaticOrder, false, GEMM_SP2>(ldsl, g, S, E); }
        { pg8::Gemm g{QB, Wb, M, DM, 512}; pg8::StaticOrder S; S.init(M, DM, G, bx); pg8::EpiGate<true> E{ws};
          pg8::gemm_phase<pg8::EpiGate<true>, pg8::StaticOrder, false, GEMM_SP2>(ldsl, g, S, E); }
    }
    SEAM(6);
    if (IN(7)) {
        pg8::Gemm g{MG, Wo, M, DM, DM}; pg8::StaticOrder S; S.init(M, DM, G, bx);
        pg8::EpiResid<true> E{out, out, MP, out, 1.0f, ws};
        pg8::gemm_phase<pg8::EpiResid<true>, pg8::StaticOrder, false, GEMM_SP2>(ldsl, g, S, E);
    }
    SEAM(7);
    if (IN(9)) {
        pg8::Gemm g{XN, W2in, M, 2 * DFF, DM}; pg8::StaticOrder S; S.init(M, 2 * DFF, G, bx);
        pg8::EpiSwiglu E{ws, true};
        pg8::gemm_phase<pg8::EpiSwiglu, pg8::StaticOrder, GEMM_ALIGN, GEMM_SP2>(ldsl, g, S, E);
    }
    SEAM(9);
    if (IN(10)) {
        pg8::Gemm g{ACT, W2out, M, DM, DFF}; pg8::StaticOrder S; S.init(M, DM, G, bx);
        pg8::EpiFinal E{out, ws, args.in[17]};
        pg8::gemm_phase<pg8::EpiFinal, pg8::StaticOrder, true, GEMM_SP2>(ldsl, g, S, E);
    }
#undef IN
#undef SEAM
}

extern "C" void kernel_launch(void* const* d_in, const int* in_sizes, int n_in, void* d_out, int out_size, void* d_ws, size_t ws_size, hipStream_t stream) {
    static int grid = 0;
    if (grid == 0) {
        if (n_in != 18 || in_sizes[0] != MP * DM || in_sizes[1] != MS * DM || out_size != M * DM || ws_size < WS_END) {
            fprintf(stderr, "kernel_launch: shape/workspace mismatch (n_in %d, in0 %d, in1 %d, out %d, ws %zu); nothing launched\n", n_in, n_in > 0 ? in_sizes[0] : -1, n_in > 1 ? in_sizes[1] : -1, out_size, ws_size); grid = -1; return; }
        int dev = 0, cus = 0, per_cu = 0;
        if (hipGetDevice(&dev) != hipSuccess || hipDeviceGetAttribute(&cus, hipDeviceAttributeMultiprocessorCount, dev) != hipSuccess) { fprintf(stderr, "kernel_launch: device query failed\n"); grid = -1; return; }
        if (hipFuncSetAttribute((const void*)mega_fwd, hipFuncAttributeMaxDynamicSharedMemorySize, LDS_BYTES) != hipSuccess) { fprintf(stderr, "kernel_launch: hipFuncSetAttribute failed\n"); grid = -1; return; }
        if (hipOccupancyMaxActiveBlocksPerMultiprocessor(&per_cu, (const void*)mega_fwd, NWAVES * 64, LDS_BYTES) != hipSuccess || per_cu < 1) { fprintf(stderr, "kernel_launch: occupancy query says %d\n", per_cu); per_cu = 1; }
        (void)hipGetLastError();
        grid = cus;
    }
    if (grid < 0) return;
    if (hipMemsetAsync(d_ws, 0, 131072, stream) != hipSuccess) { fprintf(stderr, "kernel_launch: hipMemsetAsync of the barrier words failed\n"); return; }
    Args a{};
    for (int i = 0; i < 18; ++i) a.in[i] = (const float*)d_in[i];
    a.out = (float*)d_out; a.ws = (unsigned char*)d_ws;
    a.ph_lo = 0; a.ph_hi = N_PHASES;
    void* kargs[] = {&a};
    const hipError_t e = hipLaunchCooperativeKernel((const void*)mega_fwd, dim3(grid), dim3(NWAVES * 64), kargs, LDS_BYTES, stream);
    if (e != hipSuccess) fprintf(stderr, "kernel_launch: cooperative launch failed: %s (grid %d)\n", hipGetErrorString(e), grid);
}
```
